# Optimizing an MI355X kernel written in HIP

```python
import jax, jax.numpy as jnp
from jax import lax
import numpy as np

D_MODEL = 1024
BATCH = 16
SEQ = 256
DEPTH = 1
DEC_BATCH = 8
DEC_SEQ = 1024
PAST_LEN = 512

GRID_W = 64
MIX_W = D_MODEL
RET_W = MIX_W // 2
RET_HEADS = 4
RET_HEAD_DIM = RET_W // RET_HEADS
SSD_W = MIX_W - RET_W
SSD_HEAD_DIM = 64
SSD_HEADS = SSD_W // SSD_HEAD_DIM
SSD_GROUPS = 2
SSD_STATE = 128
HEADS_PER_GROUP = SSD_HEADS // SSD_GROUPS
CONV_W = 5
CONV_CH = SSD_W + 2 * SSD_GROUPS * SSD_STATE
CHUNK = 64
D_FF = -(-8 * D_MODEL // (3 * 256)) * 256
ROPE_BASE = 10000.0
EPS = 1e-6
ALPHA = (2.0 * DEPTH) ** 0.25
BETA = (8.0 * DEPTH) ** -0.25
IN_SPLITS = (RET_W, 2 * RET_W, 3 * RET_W, 4 * RET_W, 4 * RET_W + SSD_W, 4 * RET_W + SSD_W + CONV_CH)
IN_COLS = 4 * RET_W + SSD_W + CONV_CH + SSD_HEADS

kernel_name = "hymba_retention_ssd_prefix_flow_step"


def layer_norm(x, g, b):
    xf = x.astype(jnp.float32)
    mu = jnp.mean(xf, axis=-1, keepdims=True)
    var = jnp.mean(jnp.square(xf - mu), axis=-1, keepdims=True)
    y = (xf - mu) * lax.rsqrt(var + EPS) * g.astype(jnp.float32) + b.astype(jnp.float32)
    return y.astype(x.dtype)


def rms_norm(x):
    xf = x.astype(jnp.float32)
    return xf * lax.rsqrt(jnp.mean(jnp.square(xf), axis=-1, keepdims=True) + EPS)


def rope_2d(n_tokens):
    rows = n_tokens // GRID_W
    t_row = jnp.repeat(jnp.arange(rows, dtype=jnp.float32), GRID_W)
    t_col = jnp.tile(jnp.arange(GRID_W, dtype=jnp.float32), rows)
    nf = RET_HEAD_DIM // 4
    inv = ROPE_BASE ** (-jnp.arange(nf, dtype=jnp.float32) / nf)
    ang = jnp.concatenate([t_row[:, None] * inv, t_col[:, None] * inv], axis=-1)
    return jnp.cos(ang), jnp.sin(ang)


def apply_rope(x, cos, sin):
    half = x.shape[-1] // 2
    x1 = x[..., :half].astype(jnp.float32)
    x2 = x[..., half:].astype(jnp.float32)
    return jnp.concatenate([x1 * cos - x2 * sin, x1 * sin + x2 * cos], axis=-1).astype(x.dtype)


def chunked_scan(q, k, v, log_a, s0, inclusive):
    f32 = jnp.float32
    b, h, L, dk = q.shape
    dv = v.shape[-1]
    n = L // CHUNK
    qc = q.astype(f32).reshape(b, h, n, CHUNK, dk)
    kc = k.astype(f32).reshape(b, h, n, CHUNK, dk)
    vc = v.astype(f32).reshape(b, h, n, CHUNK, dv)
    cum = jnp.cumsum(log_a.astype(f32).reshape(b, h, n, CHUNK), axis=-1)
    idx = jnp.arange(CHUNK)
    mask = (idx[:, None] >= idx[None, :]) if inclusive else (idx[:, None] > idx[None, :])
    decay = jnp.exp(jnp.where(mask, cum[..., :, None] - cum[..., None, :], -jnp.inf))
    scores = jnp.einsum('bhnid,bhnjd->bhnij', qc, kc) * decay
    intra = jnp.einsum('bhnij,bhnje->bhnie', scores, vc)
    tail = jnp.exp(cum[..., -1:] - cum)
    chunk_state = jnp.einsum('bhnj,bhnjd,bhnje->bhnde', tail, kc, vc)
    chunk_decay = jnp.exp(cum[..., -1])

    def step(s, inp):
        dec, cs = inp
        return dec[..., None, None] * s + cs, s

    s_final, s_enter = lax.scan(step, s0.astype(f32),
                                (jnp.moveaxis(chunk_decay, 2, 0), jnp.moveaxis(chunk_state, 2, 0)))
    s_enter = jnp.moveaxis(s_enter, 0, 2)
    cross = jnp.einsum('bhnid,bhnde->bhnie', qc * jnp.exp(cum)[..., None], s_enter)
    return (intra + cross).reshape(b, h, L, dv), s_final


def bidir_scan(q, k, v_f, v_b, log_a_f, log_a_b, s0_f, s0_b):
    o_f, s_f = chunked_scan(q, k, v_f, log_a_f, s0_f, True)
    flip = lambda t: jnp.flip(t, axis=2)
    o_b, s_b = chunked_scan(flip(q), flip(k), flip(v_b), flip(log_a_b), s0_b, False)
    return o_f + flip(o_b), s_f, s_b


def depthwise_conv(x, w, b):
    y = lax.conv_general_dilated(x, w[:, None, :], window_strides=(1,),
                                 padding=[(CONV_W // 2, CONV_W // 2)],
                                 dimension_numbers=('NWC', 'WIO', 'NWC'),
                                 feature_group_count=x.shape[-1])
    return y + b


def adaln(cond, w_ada, b_ada):
    return jax.nn.silu(cond) @ w_ada + b_ada


def trunk_layer(x, mod, rope, s_ret0, s_ssd0, p):
    bsz, L, _ = x.shape
    sh1, sc1, g1, sh2, sc2, g2 = jnp.split(mod, 6, axis=-1)
    h = x * (1 + sc1) + sh1
    proj = h @ p['w_in']
    q, k, v, g, z, xbc, dt_raw = jnp.split(proj, IN_SPLITS, axis=-1)

    heads = lambda t: t.reshape(bsz, L, RET_HEADS, RET_HEAD_DIM).transpose(0, 2, 1, 3)
    q, k, v = heads(q), heads(k), heads(v)
    if rope is not None:
        q = apply_rope(q, rope[0], rope[1])
        k = apply_rope(k, rope[0], rope[1])
    k = k * (RET_HEAD_DIM ** -0.5)
    lg_f = jnp.broadcast_to(jax.nn.log_sigmoid(p['ret_decay_fwd'].astype(jnp.float32))[None, :, None], (bsz, RET_HEADS, L))
    lg_b = jnp.broadcast_to(jax.nn.log_sigmoid(p['ret_decay_bwd'].astype(jnp.float32))[None, :, None], (bsz, RET_HEADS, L))
    o_ret, sr_f, sr_b = bidir_scan(q, k, v, v, lg_f, lg_b, s_ret0[0], s_ret0[1])
    o_ret = rms_norm(o_ret).transpose(0, 2, 1, 3).reshape(bsz, L, RET_W).astype(x.dtype)
    o_ret = jax.nn.silu(g) * o_ret

    xbc = jax.nn.silu(depthwise_conv(xbc, p['conv_w'], p['conv_b']))
    xs, bm, cm = jnp.split(xbc, (SSD_W, SSD_W + SSD_GROUPS * SSD_STATE), axis=-1)
    xs = xs.reshape(bsz, L, SSD_HEADS, SSD_HEAD_DIM).transpose(0, 2, 1, 3)
    grp = lambda t: jnp.repeat(t.reshape(bsz, L, SSD_GROUPS, SSD_STATE), HEADS_PER_GROUP, axis=2).transpose(0, 2, 1, 3)
    bm, cm = grp(bm), grp(cm)
    dt_raw = dt_raw.astype(jnp.float32)
    dt_f = jax.nn.softplus(dt_raw + p['dt_bias_fwd'].astype(jnp.float32)).transpose(0, 2, 1)
    dt_b = jax.nn.softplus(dt_raw + p['dt_bias_bwd'].astype(jnp.float32)).transpose(0, 2, 1)
    la_f = dt_f * (-jnp.exp(p['a_log_fwd'].astype(jnp.float32)))[None, :, None]
    la_b = dt_b * (-jnp.exp(p['a_log_bwd'].astype(jnp.float32)))[None, :, None]
    xsf = xs.astype(jnp.float32)
    y, ss_f, ss_b = bidir_scan(cm, bm, xsf * dt_f[..., None], xsf * dt_b[..., None], la_f, la_b, s_ssd0[0], s_ssd0[1])
    y = y + p['d_skip'].astype(jnp.float32)[None, :, None, None] * xsf
    y = y.transpose(0, 2, 1, 3).reshape(bsz, L, SSD_W)
    o_ssd = (rms_norm(y * jax.nn.silu(z.astype(jnp.float32))) * p['ssd_norm_w'].astype(jnp.float32)).astype(x.dtype)

    mix = jnp.concatenate([o_ret, o_ssd], axis=-1) @ p['w_out']
    x = layer_norm(ALPHA * x + g1 * mix, p['ln1_g'], p['ln1_b'])
    h2 = x * (1 + sc2) + sh2
    ffn = (jax.nn.silu(h2 @ p['w_gate']) * (h2 @ p['w_up'])) @ p['w_down']
    x = layer_norm(ALPHA * x + g2 * ffn, p['ln2_g'], p['ln2_b'])
    s_ret = jnp.stack([sr_f, sr_b], axis=1).astype(x.dtype)
    s_ssd = jnp.stack([ss_f, ss_b], axis=1).astype(x.dtype)
    return x, s_ret, s_ssd


def setup_inputs(seed: int = 0) -> dict:
    key = jax.random.key(seed)
    ks = jax.random.split(key, 32)
    f32 = jnp.float32
    nrm = lambda k, shape, s: jax.random.normal(k, shape, f32) * s
    gamma0 = 1.0 - 2.0 ** (-5.0 - np.arange(RET_HEADS))
    logit0 = jnp.asarray(np.log(gamma0 / (1.0 - gamma0)), f32)
    dt_f = jnp.exp(jax.random.uniform(ks[12], (DEPTH, SSD_HEADS), f32, np.log(1e-3), np.log(1e-1)))
    dt_b = jnp.exp(jax.random.uniform(ks[13], (DEPTH, SSD_HEADS), f32, np.log(1e-3), np.log(1e-1)))
    inv_sp = lambda d: d + jnp.log(-jnp.expm1(-d))
    return {
        'x_prompt': nrm(ks[0], (BATCH, SEQ, D_MODEL), 1.0),
        'x_sample': nrm(ks[1], (DEC_BATCH, DEC_SEQ, D_MODEL), 1.0),
        'state_ret': nrm(ks[2], (DEC_BATCH, DEPTH, 2, RET_HEADS, RET_HEAD_DIM, RET_HEAD_DIM), 0.1),
        'state_ssd': nrm(ks[3], (DEC_BATCH, DEPTH, 2, SSD_HEADS, SSD_STATE, SSD_HEAD_DIM), 0.1),
        'c': nrm(ks[4], (DEC_BATCH, D_MODEL), 1.0),
        'c_ctx': nrm(ks[5], (D_MODEL,), 0.5),
        'w_in': nrm(ks[6], (DEPTH, D_MODEL, IN_COLS), D_MODEL ** -0.5),
        'ret_decay_fwd': logit0[None, :] + nrm(ks[7], (DEPTH, RET_HEADS), 0.05),
        'ret_decay_bwd': logit0[None, :] + nrm(ks[8], (DEPTH, RET_HEADS), 0.05),
        'conv_w': nrm(ks[9], (DEPTH, CONV_W, CONV_CH), CONV_W ** -0.5),
        'conv_b': nrm(ks[10], (DEPTH, CONV_CH), 0.02),
        'dt_bias_fwd': inv_sp(dt_f),
        'dt_bias_bwd': inv_sp(dt_b),
        'a_log_fwd': jnp.log(jax.random.uniform(ks[14], (DEPTH, SSD_HEADS), f32, 1.0, 16.0)),
        'a_log_bwd': jnp.log(jax.random.uniform(ks[15], (DEPTH, SSD_HEADS), f32, 1.0, 16.0)),
        'd_skip': 1.0 + nrm(ks[16], (DEPTH, SSD_HEADS), 0.1),
        'ssd_norm_w': 1.0 + nrm(ks[17], (DEPTH, SSD_W), 0.1),
        'w_out': nrm(ks[18], (DEPTH, MIX_W, D_MODEL), BETA * MIX_W ** -0.5),
        'ln1_g': 1.0 + nrm(ks[19], (DEPTH, D_MODEL), 0.05),
        'ln1_b': nrm(ks[20], (DEPTH, D_MODEL), 0.02),
        'w_gate': nrm(ks[21], (DEPTH, D_MODEL, D_FF), D_MODEL ** -0.5),
        'w_up': nrm(ks[22], (DEPTH, D_MODEL, D_FF), D_MODEL ** -0.5),
        'w_down': nrm(ks[23], (DEPTH, D_FF, D_MODEL), BETA * D_FF ** -0.5),
        'ln2_g': 1.0 + nrm(ks[24], (DEPTH, D_MODEL), 0.05),
        'ln2_b': nrm(ks[25], (DEPTH, D_MODEL), 0.02),
        'w_ada': nrm(ks[26], (DEPTH, D_MODEL, 6 * D_MODEL), 0.5 * D_MODEL ** -0.5),
        'b_ada': nrm(ks[27], (DEPTH, 6 * D_MODEL), 0.02),
    }


def reference(x_prompt, x_sample, state_ret, state_ssd, c, c_ctx, w_in, ret_decay_fwd, ret_decay_bwd,
              conv_w, conv_b, dt_bias_fwd, dt_bias_bwd, a_log_fwd, a_log_bwd, d_skip, ssd_norm_w,
              w_out, ln1_g, ln1_b, w_gate, w_up, w_down, ln2_g, ln2_b, w_ada, b_ada):
    rope = rope_2d(x_sample.shape[1])
    xp, xs = x_prompt, x_sample
    bp = x_prompt.shape[0]
    new_ret, new_ssd = [], []
    for l in range(DEPTH):
        p = {'w_in': w_in[l], 'ret_decay_fwd': ret_decay_fwd[l], 'ret_decay_bwd': ret_decay_bwd[l],
             'conv_w': conv_w[l], 'conv_b': conv_b[l], 'dt_bias_fwd': dt_bias_fwd[l], 'dt_bias_bwd': dt_bias_bwd[l],
             'a_log_fwd': a_log_fwd[l], 'a_log_bwd': a_log_bwd[l], 'd_skip': d_skip[l], 'ssd_norm_w': ssd_norm_w[l],
             'w_out': w_out[l], 'ln1_g': ln1_g[l], 'ln1_b': ln1_b[l], 'w_gate': w_gate[l], 'w_up': w_up[l],
             'w_down': w_down[l], 'ln2_g': ln2_g[l], 'ln2_b': ln2_b[l]}
        mod_ctx = adaln(c_ctx[None, :], w_ada[l], b_ada[l])[:, None, :]
        mod_lat = adaln(c, w_ada[l], b_ada[l])[:, None, :]
        zr = jnp.zeros((bp, RET_HEADS, RET_HEAD_DIM, RET_HEAD_DIM), xp.dtype)
        zs = jnp.zeros((bp, SSD_HEADS, SSD_STATE, SSD_HEAD_DIM), xp.dtype)
        xp, s_ret, s_ssd = trunk_layer(xp, mod_ctx, None, (zr, zr), (zs, zs), p)
        new_ret.append(s_ret)
        new_ssd.append(s_ssd)
        xs, _, _ = trunk_layer(xs, mod_lat, rope, (state_ret[:, l, 0], state_ret[:, l, 1]),
                               (state_ssd[:, l, 0], state_ssd[:, l, 1]), p)
    new_state_ret = jnp.stack(new_ret, axis=1)
    new_state_ssd = jnp.stack(new_ssd, axis=1)
    return (xp, xs, new_state_ret, new_state_ssd)
```

```cpp
#include <hip/hip_runtime.h>
#include <cstdio>
#include <cstdint>
namespace pg8 {
#define PG8_LAS __attribute__((address_space(3)))
typedef unsigned short bf16_t;
typedef short bf16x8 __attribute__((ext_vector_type(8)));
typedef float f32x4 __attribute__((ext_vector_type(4)));
typedef unsigned u32x4 __attribute__((ext_vector_type(4)));
constexpr int BM = 256, BK = 64, HALF = 128, HTB = HALF * BK * 2  , STAGE_BYTES = 8 * HTB, NXCD = 8, WGM = 8;

__host__ __device__ __forceinline__ int lds_byte(int r, int c) { const int st = (r >> 4) * 2 + (c >> 5), rr = r & 15, cc = c & 31, ob = rr * 64 + cc * 2; return st * 1024 + (ob ^ (((ob >> 9) & 1) << 5)); }
__host__ __device__ __forceinline__ void stage_rc(int b, int& R, int& C) { const int st = b / 1024, sb = b % 1024, swz = sb ^ (((sb >> 9) & 1) << 5); R = (st >> 1) * 16 + swz / 64; C = (st & 1) * 32 + (swz % 64) / 2; }
__host__ __device__ __forceinline__ int perm32(int rho) { const int n = rho >> 4, i = rho & 15; return 8 * (i >> 2) + 4 * n + (i & 3); }

struct Unit { int pm, pn; };
struct Gemm { const bf16_t* A; const bf16_t* Bt; int M, N, K; };

struct StaticOrder {
    int nM, nN, nwg, G, c;
    __host__ __device__ void init(int M, int N, int G_, int c_) { nM = M / BM; nN = N / BM; nwg = nM * nN; G = G_; c = c_; }
    __host__ __device__ bool next(int i, Unit& u) const {
        const long L = (long)i * G + c; if (L >= nwg) return false;
        int wgid = (int)L; { const int q = nwg / NXCD, r = nwg % NXCD, xcd = wgid % NXCD, off = wgid / NXCD; wgid = (xcd < r ? xcd * (q + 1) : r * (q + 1) + (xcd - r) * q) + off; }
        const int nig = WGM * nN, gid = wgid / nig, fm = gid * WGM, gsz = (nM - fm) < WGM ? (nM - fm) : WGM;
        u.pm = fm + ((wgid % nig) % gsz); u.pn = (wgid % nig) / gsz; return true;
    }
    __device__ __forceinline__ void a_ready(const Unit&) const {}
    __device__ __forceinline__ void done(const Unit&) const {}
};

__device__ __forceinline__ unsigned cvt_pk_bf16(float lo, float hi) { unsigned r; asm volatile("v_cvt_pk_bf16_f32 %0, %1, %2" : "=v"(r) : "v"(lo), "v"(hi)); return r; }
typedef unsigned u32x2 __attribute__((ext_vector_type(2)));
__device__ __forceinline__ float silu_f(float x) { return x / (1.0f + __expf(-x)); }

struct EpiIn {
    static constexpr bool PERM = false, AFTER_DRAIN = false;
    bf16_t* P; const float* rope;
    __device__ __forceinline__ void operator()(const f32x4 (&acc)[2][2][4][2], const Unit& u, int wr, int wc, int fr, int fq) const {
        const int row0 = u.pm * BM + wr * 64 + fr;
        if (u.pn < 4) {
            const bool lat = u.pm >= 16; const float ksc = (u.pn >= 2) ? 0.08838834764831845f : 1.0f;
            const int i0 = 16 * wc + 4 * fq;
#pragma unroll
            for (int ai = 0; ai < 2; ++ai)
#pragma unroll
                for (int m = 0; m < 4; ++m) {
                    const int row = row0 + ai * HALF + m * 16;
                    f32x4 cs0 = (f32x4){1.f, 0.f, 1.f, 0.f}, cs1 = cs0;
                    if (lat) { const int t = (row - 4096) & 1023; const int pos = (wc < 2) ? (t >> 6) : (t & 63); const float* rp = rope + ((size_t)pos * 32 + (i0 & 31)) * 2; cs0 = *(const f32x4*)rp; cs1 = *(const f32x4*)(rp + 4); }
                    bf16_t* rowp = P + (size_t)row * 3584 + u.pn * BM + i0;
#pragma unroll
                    for (int bj = 0; bj < 2; ++bj) {
                        const f32x4 x1 = acc[ai][bj][m][0], x2 = acc[ai][bj][m][1];
                        f32x4 y1, y2;
                        y1[0] = (x1[0] * cs0[0] - x2[0] * cs0[1]) * ksc; y2[0] = (x1[0] * cs0[1] + x2[0] * cs0[0]) * ksc;
                        y1[1] = (x1[1] * cs0[2] - x2[1] * cs0[3]) * ksc; y2[1] = (x1[1] * cs0[3] + x2[1] * cs0[2]) * ksc;
                        y1[2] = (x1[2] * cs1[0] - x2[2] * cs1[1]) * ksc; y2[2] = (x1[2] * cs1[1] + x2[2] * cs1[0]) * ksc;
                        y1[3] = (x1[3] * cs1[2] - x2[3] * cs1[3]) * ksc; y2[3] = (x1[3] * cs1[3] + x2[3] * cs1[2]) * ksc;
                        u32x2 w1, w2; w1.x = cvt_pk_bf16(y1[0], y1[1]); w1.y = cvt_pk_bf16(y1[2], y1[3]); w2.x = cvt_pk_bf16(y2[0], y2[1]); w2.y = cvt_pk_bf16(y2[2], y2[3]);
                        *(u32x2*)(rowp + bj * HALF) = w1; *(u32x2*)(rowp + bj * HALF + 64) = w2;
                    }
                }
        } else {
            const int col0 = u.pn * BM + wc * 32 + 8 * fq;
#pragma unroll
            for (int ai = 0; ai < 2; ++ai)
#pragma unroll
                for (int m = 0; m < 4; ++m) { bf16_t* rowp = P + (size_t)(row0 + ai * HALF + m * 16) * 3584 + col0;
#pragma unroll
                    for (int bj = 0; bj < 2; ++bj) { const f32x4 v0 = acc[ai][bj][m][0], v1 = acc[ai][bj][m][1];
                        u32x4 w; w.x = cvt_pk_bf16(v0[0], v0[1]); w.y = cvt_pk_bf16(v0[2], v0[3]); w.z = cvt_pk_bf16(v1[0], v1[1]); w.w = cvt_pk_bf16(v1[2], v1[3]);
                        *(u32x4*)(rowp + bj * HALF) = w; } }
        }
    }
};
struct EpiRes {
    static constexpr bool PERM = false, AFTER_DRAIN = false;
    float* T; const float* base0; const float* base1; const float* gate  ; float alpha;
    __device__ __forceinline__ void operator()(const f32x4 (&acc)[2][2][4][2], const Unit& u, int wr, int wc, int fr, int fq) const {
        const int row0 = u.pm * BM + wr * 64 + fr, col0 = u.pn * BM + wc * 32 + 4 * fq;
        const int cond = (u.pm < 16) ? 0 : 1 + ((u.pm - 16) >> 2);
        const float* bs = (u.pm < 16) ? base0 : base1 - (size_t)4096 * 1024;
        const float* gp = gate + (size_t)cond * 6144 + col0;
        f32x4 gv[2][2];
#pragma unroll
        for (int bj = 0; bj < 2; ++bj)
#pragma unroll
            for (int n = 0; n < 2; ++n) gv[bj][n] = *(const f32x4*)(gp + bj * HALF + n * 16);
#pragma unroll
        for (int ai = 0; ai < 2; ++ai)
#pragma unroll
            for (int m = 0; m < 4; ++m) { const size_t off = (size_t)(row0 + ai * HALF + m * 16) * 1024 + col0;
#pragma unroll
                for (int bj = 0; bj < 2; ++bj)
#pragma unroll
                    for (int n = 0; n < 2; ++n) { const f32x4 b = *(const f32x4*)(bs + off + bj * HALF + n * 16); *(f32x4*)(T + off + bj * HALF + n * 16) = b * alpha + gv[bj][n] * acc[ai][bj][m][n]; } }
    }
};
struct EpiGU {
    static constexpr bool PERM = false, AFTER_DRAIN = false;
    bf16_t* ACT;
    __device__ __forceinline__ void operator()(const f32x4 (&acc)[2][2][4][2], const Unit& u, int wr, int wc, int fr, int fq) const {
        const int row0 = u.pm * BM + wr * 64 + fr, col0 = u.pn * HALF + wc * 32 + 8 * fq;
#pragma unroll
        for (int ai = 0; ai < 2; ++ai)
#pragma unroll
            for (int m = 0; m < 4; ++m) { bf16_t* rowp = ACT + (size_t)(row0 + ai * HALF + m * 16) * 2816 + col0;
                f32x4 v0, v1;
#pragma unroll
                for (int e = 0; e < 4; ++e) { v0[e] = silu_f(acc[ai][0][m][0][e]) * acc[ai][1][m][0][e]; v1[e] = silu_f(acc[ai][0][m][1][e]) * acc[ai][1][m][1][e]; }
                u32x4 w; w.x = cvt_pk_bf16(v0[0], v0[1]); w.y = cvt_pk_bf16(v0[2], v0[3]); w.z = cvt_pk_bf16(v1[0], v1[1]); w.w = cvt_pk_bf16(v1[2], v1[3]);
                *(u32x4*)rowp = w; }
    }
};

template <class Epi, class Sched, bool ALIGN_EPI = false, bool SP2 = false>
__device__ __forceinline__ void gemm_phase(PG8_LAS unsigned char* lds, const Gemm g, const Sched& S, const Epi& E) {
    const int tid = threadIdx.x, wid = __builtin_amdgcn_readfirstlane(tid >> 6), lane = tid & 63, wr = wid >> 2, wc = wid & 3, fr = lane & 15, fq = lane >> 4;
    const int K = g.K, nt = K / BK;
    unsigned voffA[2], voffB[2];
#pragma unroll
    for (int i = 0; i < 2; ++i) { int R, C; stage_rc(tid * 16 + i * 8192, R, C); const int Rb = Epi::PERM ? ((R & ~31) + perm32(R & 31)) : R;
        voffA[i] = (unsigned)(R * K + C) * 2u; voffB[i] = (unsigned)(Rb * K + C) * 2u; }
    const size_t kstep = (size_t)(BK * 2);
    const size_t hstep = (size_t)HALF * K * 2;
    const size_t tstep = 2 * hstep;
    const unsigned ldsw = (unsigned)wid * 1024u;
    const int aoff = lds_byte(wr * 64 + fr, fq * 8), boff = lds_byte(wc * 32 + fr, fq * 8);
#define PG8_SA(b, h) (((b) * 2 + (h)) * HTB)
#define PG8_SB(b, h) ((4 + (b) * 2 + (h)) * HTB)
#define PG8_STAGE(bufoff, gbase, voff) do { _Pragma("unroll") for (int _i = 0; _i < 2; ++_i) \
        __builtin_amdgcn_global_load_lds((const unsigned*)((const char*)(gbase) + (voff)[_i]), (PG8_LAS unsigned*)(lds + (bufoff) + ldsw + _i * 8192), 16, 0, 0); } while (0)
#define PG8_LDA(dst, b, h) do { _Pragma("unroll") for (int m = 0; m < 4; ++m) _Pragma("unroll") for (int k = 0; k < 2; ++k) dst[m][k] = *(const PG8_LAS bf16x8*)(lds + PG8_SA(b, h) + aoff + m * 2048 + k * 1024); } while (0)
#define PG8_LDB(dst, b, h) do { _Pragma("unroll") for (int n = 0; n < 2; ++n) _Pragma("unroll") for (int k = 0; k < 2; ++k) dst[n][k] = *(const PG8_LAS bf16x8*)(lds + PG8_SB(b, h) + boff + n * 2048 + k * 1024); } while (0)
#define PG8_MMA(ai, bj, At, Bt) do { __builtin_amdgcn_s_setprio(1); _Pragma("unroll") for (int m = 0; m < 4; ++m) _Pragma("unroll") for (int n = 0; n < 2; ++n) _Pragma("unroll") for (int k = 0; k < 2; ++k) \
        acc[ai][bj][m][n] = __builtin_amdgcn_mfma_f32_16x16x32_bf16(Bt[n][k], At[m][k], acc[ai][bj][m][n], 0, 0, 0); __builtin_amdgcn_s_setprio(0); } while (0)
#define PG8_WAIT_V(n) asm volatile("s_waitcnt vmcnt(" #n ")" ::: "memory")
#define PG8_WAIT_L(n) asm volatile("s_waitcnt lgkmcnt(" #n ")" ::: "memory")
#define PG8_BAR __builtin_amdgcn_s_barrier()
#define PG8_SCHED __builtin_amdgcn_sched_barrier(0)
    Unit cur, nxt; int ui = 0;
    if (!S.next(0, cur)) return;
    f32x4 acc[2][2][4][2];
#pragma unroll
    for (int a = 0; a < 2; ++a)
#pragma unroll
        for (int b = 0; b < 2; ++b)
#pragma unroll
            for (int m = 0; m < 4; ++m)
#pragma unroll
                for (int n = 0; n < 2; ++n) acc[a][b][m][n] = (f32x4){0.f, 0.f, 0.f, 0.f};
    bf16x8 At[4][2], B0[2][2], B1[2][2];
    const char* cA = (const char*)g.A + (size_t)cur.pm * tstep; const char* cB = (const char*)g.Bt + (size_t)cur.pn * tstep;
    S.a_ready(cur);
    if constexpr (SP2) {
        PG8_STAGE(PG8_SB(0, 0), cB, voffB); PG8_STAGE(PG8_SB(0, 1), cB + hstep, voffB); PG8_STAGE(PG8_SA(0, 0), cA, voffA); PG8_STAGE(PG8_SA(0, 1), cA + hstep, voffA);
        if (wr == 1) PG8_BAR;
        PG8_WAIT_V(2); PG8_BAR;
        PG8_STAGE(PG8_SB(1, 0), cB + kstep, voffB); PG8_STAGE(PG8_SA(1, 0), cA + kstep, voffA); PG8_STAGE(PG8_SB(1, 1), cB + hstep + kstep, voffB);
        PG8_WAIT_V(6); PG8_BAR;
    } else {
        PG8_STAGE(PG8_SB(0, 0), cB, voffB); PG8_STAGE(PG8_SA(0, 0), cA, voffA); PG8_STAGE(PG8_SB(0, 1), cB + hstep, voffB); PG8_STAGE(PG8_SA(0, 1), cA + hstep, voffA);
        if (wr == 1) PG8_BAR;
        PG8_WAIT_V(4); PG8_BAR;
        PG8_STAGE(PG8_SB(1, 0), cB + kstep, voffB); PG8_STAGE(PG8_SA(1, 0), cA + kstep, voffA); PG8_STAGE(PG8_SB(1, 1), cB + hstep + kstep, voffB);
        PG8_WAIT_V(6); PG8_BAR;
    }
    for (;;) {
        const bool has_next = S.next(ui + 1, nxt);
        const char* nA = has_next ? (const char*)g.A + (size_t)nxt.pm * tstep : cA; const char* nB = has_next ? (const char*)g.Bt + (size_t)nxt.pn * tstep : cB;
        for (int t = 0; t < nt; t += 2) {
            const bool last = (t == nt - 2);
            const char* a1 = cA + (size_t)(t + 1) * kstep;
            const char* a2 = last ? nA : cA + (size_t)(t + 2) * kstep; const char* b2 = last ? nB : cB + (size_t)(t + 2) * kstep;
            const char* a3 = a2 + kstep; const char* b3 = b2 + kstep;
            if (last && has_next) S.a_ready(nxt);
            if constexpr (SP2) {
            PG8_LDB(B0, 0, 0); PG8_LDB(B1, 0, 1); PG8_SCHED; PG8_LDA(At, 0, 0); PG8_STAGE(PG8_SA(1, 1), a1 + hstep, voffA);
            PG8_WAIT_V(8); PG8_WAIT_L(0); PG8_BAR; PG8_MMA(0, 0, At, B0); PG8_MMA(0, 1, At, B1); PG8_BAR; PG8_SCHED;
            PG8_LDA(At, 0, 1); PG8_STAGE(PG8_SB(0, 0), b2, voffB); PG8_STAGE(PG8_SB(0, 1), b2 + hstep, voffB); PG8_STAGE(PG8_SA(0, 0), a2, voffA);
            PG8_WAIT_V(8); PG8_WAIT_L(0); PG8_BAR; PG8_MMA(1, 0, At, B0); PG8_MMA(1, 1, At, B1); PG8_BAR; PG8_SCHED;
            PG8_LDB(B0, 1, 0); PG8_LDB(B1, 1, 1); PG8_SCHED; PG8_LDA(At, 1, 0); PG8_STAGE(PG8_SA(0, 1), a2 + hstep, voffA);
            PG8_WAIT_V(8); PG8_WAIT_L(0); PG8_BAR; PG8_MMA(0, 0, At, B0); PG8_MMA(0, 1, At, B1); PG8_BAR; PG8_SCHED;
            PG8_LDA(At, 1, 1); PG8_STAGE(PG8_SB(1, 0), b3, voffB); PG8_STAGE(PG8_SB(1, 1), b3 + hstep, voffB); PG8_STAGE(PG8_SA(1, 0), a3, voffA);
            PG8_WAIT_V(8); PG8_WAIT_L(0); PG8_BAR; PG8_MMA(1, 0, At, B0); PG8_MMA(1, 1, At, B1); PG8_BAR; PG8_SCHED;
            } else {
            PG8_LDB(B0, 0, 0); PG8_SCHED; PG8_LDA(At, 0, 0); PG8_STAGE(PG8_SA(1, 1), a1 + hstep, voffA);
            PG8_WAIT_L(8); PG8_BAR; PG8_WAIT_L(0); PG8_MMA(0, 0, At, B0); PG8_BAR; PG8_SCHED;
            PG8_LDB(B1, 0, 1); PG8_STAGE(PG8_SB(0, 0), b2, voffB);
            PG8_BAR; PG8_WAIT_L(0); PG8_MMA(0, 1, At, B1); PG8_BAR;
            PG8_LDA(At, 0, 1); PG8_STAGE(PG8_SA(0, 0), a2, voffA);
            PG8_BAR; PG8_WAIT_L(0); PG8_MMA(1, 0, At, B0); PG8_BAR; PG8_SCHED;
            PG8_STAGE(PG8_SB(0, 1), b2 + hstep, voffB);
            PG8_WAIT_V(6); PG8_BAR; PG8_MMA(1, 1, At, B1); PG8_BAR;
            PG8_LDB(B0, 1, 0); PG8_SCHED; PG8_LDA(At, 1, 0); PG8_STAGE(PG8_SA(0, 1), a2 + hstep, voffA);
            PG8_WAIT_L(8); PG8_BAR; PG8_WAIT_L(0); PG8_MMA(0, 0, At, B0); PG8_BAR; PG8_SCHED;
            PG8_LDB(B1, 1, 1); PG8_STAGE(PG8_SB(1, 0), b3, voffB);
            PG8_BAR; PG8_WAIT_L(0); PG8_MMA(0, 1, At, B1); PG8_BAR;
            PG8_LDA(At, 1, 1); PG8_STAGE(PG8_SA(1, 0), a3, voffA);
            PG8_BAR; PG8_WAIT_L(0); PG8_MMA(1, 0, At, B0); PG8_BAR; PG8_SCHED;
            PG8_STAGE(PG8_SB(1, 1), b3 + hstep, voffB);
            PG8_WAIT_V(6); PG8_BAR; PG8_MMA(1, 1, At, B1); PG8_BAR;
            }
        }
        if constexpr (ALIGN_EPI) { if (wr == 0) PG8_BAR; }
        if constexpr (!Epi::AFTER_DRAIN) { E(acc, cur, wr, wc, fr, fq); S.done(cur); }
        if (!has_next) break;
#pragma unroll
        for (int a = 0; a < 2; ++a)
#pragma unroll
            for (int b = 0; b < 2; ++b)
#pragma unroll
                for (int m = 0; m < 4; ++m)
#pragma unroll
                    for (int n = 0; n < 2; ++n) acc[a][b][m][n] = (f32x4){0.f, 0.f, 0.f, 0.f};
        cur = nxt; cA = nA; cB = nB; ++ui;
        if constexpr (ALIGN_EPI) { if (wr == 1) PG8_BAR; }
    }
    PG8_WAIT_V(0);
    if constexpr (!ALIGN_EPI) { if (wr == 0) PG8_BAR; }
    PG8_BAR;
    if constexpr (Epi::AFTER_DRAIN) { E.fused(acc, cur, wr, wc, fr, fq, lds, wid, lane); S.done(cur); }
#undef PG8_SA
#undef PG8_SB
#undef PG8_STAGE
#undef PG8_LDA
#undef PG8_LDB
#undef PG8_MMA
#undef PG8_WAIT_V
#undef PG8_WAIT_L
#undef PG8_BAR
#undef PG8_SCHED
}
}

constexpr int NWAVES = 8;
#ifndef MK_PER_PHASE
#define MK_PER_PHASE 0
#endif
constexpr int N_PHASES = 11;

constexpr int DM = 1024, NCTX = 4096, NLAT = 8192, MTOK = NCTX + NLAT, NPROJ = 3584, INCOLS = 3592, DFF = 2816, NGU = 2 * DFF;
constexpr int PQ = 0, PK = 512, PV = 1024, PG = 1536, PZ = 2048, PX = 2560;
constexpr float LN_EPS = 1e-6f, ALPHA = 1.189207115002721f;
constexpr size_t OUT_SR = (size_t)MTOK * DM, OUT_SS = OUT_SR + (size_t)16 * 2 * 4 * 128 * 128;

constexpr size_t MiB = 1u << 20;
constexpr size_t WS_CTL = 0, CTL_ZERO_BYTES = 1 * MiB;
constexpr size_t WS_MOD = 1 * MiB;
constexpr size_t WS_ROPE = 1 * MiB + 512 * 1024;
constexpr size_t WS_DTA = 2 * MiB;
constexpr size_t WS_DTRAW = 4 * MiB;
constexpr size_t WS_WIN = 5 * MiB, WS_WOUT = 13 * MiB, WS_WGU = 15 * MiB, WS_WD = 27 * MiB;
constexpr size_t WS_PROJ = 34 * MiB;
constexpr size_t WS_H1 = 118 * MiB, WS_XC = 118 * MiB;
constexpr size_t WS_OF = 142 * MiB;
constexpr size_t WS_A2 = 190 * MiB;
constexpr size_t WS_T1 = 34 * MiB;
constexpr size_t WS_H2 = 82 * MiB;
constexpr size_t WS_ACT = 118 * MiB;
constexpr size_t WS_T2 = 34 * MiB;
constexpr size_t WS_END = 214 * MiB;
constexpr int CW_TMO = 0, CW_BAR = 4096;

constexpr int RING_OFF = 0, RING_BYTES = 131072;
constexpr int LDSCTL_OFF = RING_BYTES, MISC_OFF = LDSCTL_OFF + 320;
constexpr int LDS_BYTES = 147456;

#define GAS __attribute__((address_space(1)))
#define LAS __attribute__((address_space(3)))
typedef unsigned short bf16;
typedef unsigned v4u __attribute__((ext_vector_type(4)));
typedef unsigned v2u __attribute__((ext_vector_type(2)));
typedef float f32x4 __attribute__((ext_vector_type(4)));
typedef GAS unsigned gu32;
#define RLX_AGENT __ATOMIC_RELAXED, __HIP_MEMORY_SCOPE_AGENT
#define LDS_WAIT() asm volatile("s_waitcnt lgkmcnt(0)" ::: "memory")
#define VM_WAIT() asm volatile("s_waitcnt vmcnt(0)" ::: "memory")
__device__ __forceinline__ unsigned f2bf(float f) { unsigned u = __builtin_bit_cast(unsigned, f); return (u + 0x7fffu + ((u >> 16) & 1u)) >> 16; }
__device__ __forceinline__ unsigned pk2(float lo, float hi) { return f2bf(lo) | (f2bf(hi) << 16); }
__device__ __forceinline__ float bf2f(unsigned short b) { return __builtin_bit_cast(float, (unsigned)b << 16); }
__device__ __forceinline__ float bflo(unsigned w) { return __builtin_bit_cast(float, w << 16); }
__device__ __forceinline__ float bfhi(unsigned w) { return __builtin_bit_cast(float, w & 0xffff0000u); }
__device__ __forceinline__ float siluf(float x) { return x / (1.0f + __expf(-x)); }
__device__ __forceinline__ float softplusf(float x) { return x > 20.f ? x : log1pf(expf(x)); }
__device__ __forceinline__ float wave_sum(float v) {
#pragma unroll
    for (int o = 1; o < 64; o <<= 1) v += __shfl_xor(v, o);
    return v;
}
#define XB_TMO      128
#define XB_XCNT(j)  (256  + 64 * (j))
#define XB_XSUB(j)  (1280 + 64 * (j))
#define XB_XGEN(j)  (2304 + 64 * (j))
#define XB_TOP      3328
#define XB_TOPGEN   3392
#define XCD_BAR_WORDS 3456
#define XB_SPIN_CAP (1u << 18)

__device__ __forceinline__ unsigned xb_ld(unsigned* p)              { return __hip_atomic_load(p, __ATOMIC_RELAXED, __HIP_MEMORY_SCOPE_AGENT); }
__device__ __forceinline__ unsigned xb_add(unsigned* p, unsigned v) { return __hip_atomic_fetch_add(p, v, __ATOMIC_RELAXED, __HIP_MEMORY_SCOPE_AGENT); }
__device__ __forceinline__ unsigned xb_xcc_id() { return (unsigned)__builtin_amdgcn_s_getreg((3 << 11) | 20) & 0xFu; }
#define XB_SPIN(cond, bar) do { unsigned _sp = 0; while (cond) { __builtin_amdgcn_s_sleep(1); \
    if ((++_sp & 255u) == 0u) { if (xb_ld(&(bar)[XB_TMO])) break; if (_sp > XB_SPIN_CAP) { atomicAdd(&(bar)[XB_TMO], 1u); break; } } } } while (0)

struct XcdBarrier {
    unsigned* bar; unsigned x;
    volatile LAS unsigned* st;
};

__device__ __forceinline__ XcdBarrier xcd_barrier_post(unsigned* bar, volatile LAS unsigned* st) {
    XcdBarrier b; b.bar = bar; b.x = xb_xcc_id(); b.st = st;
    if (threadIdx.x == 0) (void)xb_add(&bar[XB_XCNT(b.x)], 1u);
    return b;
}
__device__ __forceinline__ void xcd_barrier_complete(unsigned* bar, unsigned x, unsigned& nloc, unsigned& nx) {
    const unsigned G = gridDim.x * gridDim.y * gridDim.z;
    unsigned sum, cnt, mine, sp = 0u;
    for (;;) {
        sum = 0u; cnt = 0u; mine = 0u;
#pragma unroll
        for (unsigned j = 0; j < 16; ++j) { const unsigned c = xb_ld(&bar[XB_XCNT(j)]); sum += c; cnt += (c > 0u) ? 1u : 0u; mine = (j == x) ? c : mine; }
        if (sum == G) break;
        __builtin_amdgcn_s_sleep(1);
        if ((++sp & 255u) == 0u) { if (xb_ld(&bar[XB_TMO])) break; if (sp > XB_SPIN_CAP) { atomicAdd(&bar[XB_TMO], 1u); break; } }
    }
    nloc = mine > 0u ? mine : 1u; nx = cnt > 0u ? cnt : 1u;
}

__device__ __forceinline__ void xcd_barrier(const XcdBarrier& b) {
    asm volatile("s_waitcnt vmcnt(0)" ::: "memory");
    __syncthreads();
    if (threadIdx.x == 0) {
        unsigned* bar = b.bar;
        __builtin_amdgcn_s_waitcnt(0);
        unsigned nloc = b.st[0], nx = b.st[1];
        if (nloc == 0u) { xcd_barrier_complete(bar, b.x, nloc, nx); b.st[0] = nloc; b.st[1] = nx; }
        const unsigned old = xb_add(&bar[XB_XSUB(b.x)], 1u);
        const unsigned gen = old / nloc;
        if (old + 1u == (gen + 1u) * nloc) {
            __builtin_amdgcn_fence(__ATOMIC_RELEASE, "agent");
            asm volatile("s_waitcnt vmcnt(0)" ::: "memory");
            const unsigned og = xb_add(&bar[XB_TOP], 1u);
            const unsigned tg = og / nx;
            if (og + 1u == (tg + 1u) * nx) xb_add(&bar[XB_TOPGEN], 1u);
            else XB_SPIN(xb_ld(&bar[XB_TOPGEN]) == tg, bar);
            __builtin_amdgcn_fence(__ATOMIC_ACQUIRE, "agent");
            xb_add(&bar[XB_XGEN(b.x)], 1u);
            asm volatile("s_waitcnt vmcnt(0)" ::: "memory");
        } else {
            XB_SPIN(xb_ld(&bar[XB_XGEN(b.x)]) == gen, bar);
            __builtin_amdgcn_fence(__ATOMIC_ACQUIRE, "agent");
            asm volatile("s_waitcnt vmcnt(0)" ::: "memory");
        }
    }
    __syncthreads();
}

struct Args { const float* in[27]; float* out; unsigned char* ws; int ph_lo, ph_hi; };
struct Frame {
    LAS unsigned char* lds; volatile LAS unsigned* MISC; gu32* ctl;
    int tid, lane, wave, vcu, G;
    const float* const* in; float* out; unsigned char* ws;
};
__device__ __forceinline__ int cond_of_row(int r) { return r < NCTX ? 0 : 1 + ((r - NCTX) >> 10); }
__device__ __forceinline__ const float* xrow_ptr(const float* xp, const float* xs, int r) { return r < NCTX ? xp + (size_t)r * DM : xs + (size_t)(r - NCTX) * DM; }

__device__ __forceinline__ int srcmap_in(int n) {
    if (n < 1024) { const int l = n & 127; return (n & ~127) + 16 * (l >> 5) + (l & 15) + 64 * ((l >> 4) & 1); }
    return (n & ~31) + pg8::perm32(n & 31);
}
template <int WHICH> __device__ __forceinline__ void p0_transpose_item(const float* W, const float* W2, int K, int ld, int N, bf16* WT, LAS float* scr, int item, int lane) {
    const int nblk = N / 32, kb = item / nblk, nb = item % nblk, k0 = 64 * kb, n0 = 32 * nb;
    const int n = n0 + (lane & 31); const float* src; int sc;
    if (WHICH == 0) { src = W; sc = srcmap_in(n); }
    else if (WHICH == 1) { src = W; sc = n; }
    else { const int pn = n >> 8, jj = n & 255, l = jj & 127; src = (jj >> 7) ? W2 : W; sc = 128 * pn + (l & ~31) + pg8::perm32(l & 31); }
#pragma unroll 8
    for (int i = 0; i < 32; ++i) { const int kk = 2 * i + (lane >> 5); scr[kk * 33 + (lane & 31)] = src[(size_t)(k0 + kk) * ld + sc]; }
    LDS_WAIT(); asm volatile("" ::: "memory");
    const int c = lane & 7;
#pragma unroll
    for (int j = 0; j < 4; ++j) { const int nn = (lane >> 3) + 8 * j; const LAS float* s = scr + (8 * c) * 33 + nn;
        v4u o; o.x = pk2(s[0 * 33], s[1 * 33]); o.y = pk2(s[2 * 33], s[3 * 33]); o.z = pk2(s[4 * 33], s[5 * 33]); o.w = pk2(s[6 * 33], s[7 * 33]);
        *(GAS v4u*)(WT + (size_t)(n0 + nn) * K + k0 + 8 * c) = o; }
    LDS_WAIT(); asm volatile("" ::: "memory");
}
__device__ __forceinline__ void p0_prologue(Frame& F) {
    if (F.vcu < 96) {
        LAS float* sl = (LAS float*)(F.lds + RING_OFF);
        LAS float* red = sl + 9 * 1024;
        const float* c_lat = F.in[4]; const float* c_ctx = F.in[5];
        for (int i = F.tid; i < 9 * 1024; i += NWAVES * 64) { const int c = i >> 10, k = i & 1023; const float v = (c == 0) ? c_ctx[k] : c_lat[(size_t)(c - 1) * 1024 + k]; sl[i] = siluf(v); }
        __syncthreads();
        const int n0 = 64 * F.vcu; const float* wa = F.in[25] + n0 + F.lane;
        float acc[9];
#pragma unroll
        for (int c = 0; c < 9; ++c) acc[c] = 0.f;
        const int kbeg = 128 * F.wave;
#pragma unroll 4
        for (int k = kbeg; k < kbeg + 128; ++k) { const float w = wa[(size_t)k * 6144];
#pragma unroll
            for (int c = 0; c < 9; ++c) acc[c] += sl[c * 1024 + k] * w; }
#pragma unroll
        for (int c = 0; c < 9; ++c) red[(F.wave * 9 + c) * 64 + F.lane] = acc[c];
        __syncthreads();
        float* mod = (float*)(F.ws + WS_MOD);
        for (int i = F.tid; i < 9 * 64; i += NWAVES * 64) { const int c = i >> 6, l = i & 63; float s = F.in[26][n0 + l];
#pragma unroll
            for (int w = 0; w < 8; ++w) s += red[(w * 9 + c) * 64 + l];
            mod[(size_t)c * 6144 + n0 + l] = s; }
        __syncthreads();
    }
    if (F.vcu == F.G - 1) { float* rope = (float*)(F.ws + WS_ROPE);
        for (int i = F.tid; i < 64 * 32; i += NWAVES * 64) { const int pos = i >> 5, f = i & 31; const float inv = powf(10000.0f, -(float)f / 32.0f); const float ang = (float)pos * inv;
            rope[2 * i] = (float)cos((double)ang); rope[2 * i + 1] = (float)sin((double)ang); } }
    LAS float* scr = (LAS float*)(F.lds + RING_OFF + F.wave * 16384);
    const int gw = F.vcu * NWAVES + F.wave, NGW = F.G * NWAVES;
    constexpr int I_IN = (DM / 64) * (NPROJ / 32), I_OUT = (DM / 64) * (DM / 32), I_GU = (DM / 64) * (NGU / 32), I_D = (DFF / 64) * (DM / 32);
    constexpr int NITEMS = I_IN + I_OUT + I_GU + I_D;
    for (int it = gw; it < NITEMS; it += NGW) {
        int r = it;
        if (r < I_IN) { p0_transpose_item<0>(F.in[6], nullptr, DM, INCOLS, NPROJ, (bf16*)(F.ws + WS_WIN), scr, r, F.lane); continue; } r -= I_IN;
        if (r < I_OUT) { p0_transpose_item<1>(F.in[17], nullptr, DM, DM, DM, (bf16*)(F.ws + WS_WOUT), scr, r, F.lane); continue; } r -= I_OUT;
        if (r < I_GU) { p0_transpose_item<2>(F.in[20], F.in[21], DM, DFF, NGU, (bf16*)(F.ws + WS_WGU), scr, r, F.lane); continue; } r -= I_GU;
        p0_transpose_item<1>(F.in[22], nullptr, DFF, DM, DM, (bf16*)(F.ws + WS_WD), scr, r, F.lane);
    }
}

__device__ __forceinline__ void p1_hprep(Frame& F) {
    LAS float* wdt = (LAS float*)(F.lds + RING_OFF);
    const float* w_in = F.in[6];
    for (int i = F.tid; i < 8 * 1024; i += NWAVES * 64) { const int k = i >> 3, j = i & 7; wdt[j * 1024 + k] = w_in[(size_t)k * INCOLS + NPROJ + j]; }
    __syncthreads();
    const float* mod = (const float*)(F.ws + WS_MOD); bf16* H1 = (bf16*)(F.ws + WS_H1); float* dtraw = (float*)(F.ws + WS_DTRAW);
    const int gw = F.vcu * NWAVES + F.wave, NGW = F.G * NWAVES;
    for (int r = gw; r < MTOK; r += NGW) {
        const float* xr = xrow_ptr(F.in[0], F.in[1], r); const float* md = mod + (size_t)cond_of_row(r) * 6144;
        float d[8];
#pragma unroll
        for (int j = 0; j < 8; ++j) d[j] = 0.f;
#pragma unroll
        for (int q = 0; q < 4; ++q) { const int col = 4 * F.lane + 256 * q;
            const f32x4 x = *(const f32x4*)(xr + col), sh = *(const f32x4*)(md + col), sc = *(const f32x4*)(md + 1024 + col);
            const f32x4 h = x * (sc + 1.0f) + sh;
            v2u o; o.x = pk2(h[0], h[1]); o.y = pk2(h[2], h[3]); *(v2u*)(H1 + (size_t)r * DM + col) = o;
#pragma unroll
            for (int j = 0; j < 8; ++j) { const f32x4 w = *(const LAS f32x4*)(wdt + j * 1024 + col); d[j] += (h[0] * w[0] + h[1] * w[1]) + (h[2] * w[2] + h[3] * w[3]); } }
#pragma unroll
        for (int j = 0; j < 8; ++j) d[j] = wave_sum(d[j]);
        if (F.lane == 0) {
#pragma unroll
            for (int j = 0; j < 8; ++j) dtraw[(size_t)r * 8 + j] = d[j]; }
    }
}

__device__ __forceinline__ void p3_conv(Frame& F) {
    const bf16* PROJ = (const bf16*)(F.ws + WS_PROJ); bf16* XC = (bf16*)(F.ws + WS_XC);
    const float* cw = F.in[9]; const float* cb = F.in[10];
    const float* dtraw = (const float*)(F.ws + WS_DTRAW); float* dta = (float*)(F.ws + WS_DTA);
    const int gw = F.vcu * NWAVES + F.wave, NGW = F.G * NWAVES;
    for (int r = gw; r < MTOK; r += NGW) {
        int t, L; if (r < NCTX) { t = r & 255; L = 256; } else { t = (r - NCTX) & 1023; L = 1024; }
#pragma unroll
        for (int half = 0; half < 2; ++half) { const int c0 = 8 * F.lane + 512 * half;
            float a[8];
#pragma unroll
            for (int e = 0; e < 8; ++e) a[e] = cb[c0 + e];
#pragma unroll
            for (int w = 0; w < 5; ++w) { const int tt = t + w - 2;
                if (tt >= 0 && tt < L) { const v4u x = *(const v4u*)(PROJ + (size_t)(r + w - 2) * NPROJ + PX + c0); const float* wp = cw + w * 1024 + c0;
                    a[0] += bflo(x.x) * wp[0]; a[1] += bfhi(x.x) * wp[1]; a[2] += bflo(x.y) * wp[2]; a[3] += bfhi(x.y) * wp[3];
                    a[4] += bflo(x.z) * wp[4]; a[5] += bfhi(x.z) * wp[5]; a[6] += bflo(x.w) * wp[6]; a[7] += bfhi(x.w) * wp[7]; } }
            v4u o; o.x = pk2(siluf(a[0]), siluf(a[1])); o.y = pk2(siluf(a[2]), siluf(a[3])); o.z = pk2(siluf(a[4]), siluf(a[5])); o.w = pk2(siluf(a[6]), siluf(a[7]));
            *(v4u*)(XC + (size_t)r * DM + c0) = o; }
        if (F.lane < 8) { const int h = F.lane; const float raw = dtraw[(size_t)r * 8 + h];
            const float dtf = softplusf(raw + F.in[11][h]), dtb = softplusf(raw + F.in[12][h]);
            dta[((size_t)0 * 8 + h) * MTOK + r] = dtf; dta[((size_t)1 * 8 + h) * MTOK + r] = dtb;
            dta[((size_t)2 * 8 + h) * MTOK + r] = -dtf * expf(F.in[13][h]); dta[((size_t)3 * 8 + h) * MTOK + r] = -dtb * expf(F.in[14][h]); }
    }
}

template <int DV> __device__ __forceinline__ void p4_scan_unit(Frame& F, int seq, int h, int dir, bool ssd) {
    constexpr int NDG = 512 / DV, ND = 128 / NDG, TB = 8;
    LAS float* qs = (LAS float*)(F.lds + RING_OFF);
    LAS float* ks = qs + TB * 128;
    LAS float* vs = ks + TB * 128;
    LAS float* as_ = vs + TB * 128;
    LAS float* red = as_ + 64;
    const bf16* PROJ = (const bf16*)(F.ws + WS_PROJ); const bf16* XC = (const bf16*)(F.ws + WS_XC); const float* dta = (const float*)(F.ws + WS_DTA);
    bf16* OF = (bf16*)(F.ws + WS_OF) + (size_t)dir * MTOK * DM;
    const bool lat = seq >= 16; const int L = lat ? 1024 : 256; const int row0 = lat ? NCTX + (seq - 16) * 1024 : seq * 256;
    int e = F.tid % DV, dg = F.tid / DV; asm volatile("" : "+v"(e), "+v"(dg));
    const int d0 = dg * ND;
    float S[ND];
    if (lat) { const int b = seq - 16;
        const float* s0 = ssd ? F.in[3] + (((size_t)b * 2 + dir) * 8 + h) * 8192 : F.in[2] + (((size_t)b * 2 + dir) * 4 + h) * 16384;
#pragma unroll
        for (int i = 0; i < ND; ++i) S[i] = s0[(size_t)(d0 + i) * DV + e];
    } else {
#pragma unroll
        for (int i = 0; i < ND; ++i) S[i] = 0.f; }
    float a_const = 1.f;
    if (!ssd) { const float x = (dir ? F.in[8] : F.in[7])[h]; a_const = expf(-softplusf(-x)); }
    const int ocol = ssd ? 512 + h * 64 + e : h * 128 + e;
    for (int rd = 0; rd < L / TB; ++rd) {
        __syncthreads();
        for (int i = F.tid; i < TB * 128; i += 512) { const int tt = i >> 7, d = i & 127; const int t = dir ? (L - 1 - (rd * TB + tt)) : (rd * TB + tt); const size_t row = row0 + t;
            if (ssd) { const int g = h >> 2; qs[i] = bf2f(XC[row * DM + 768 + g * 128 + d]); ks[i] = bf2f(XC[row * DM + 512 + g * 128 + d]); }
            else { qs[i] = bf2f(PROJ[row * NPROJ + PQ + h * 128 + d]); ks[i] = bf2f(PROJ[row * NPROJ + PK + h * 128 + d]); } }
        for (int i = F.tid; i < TB * DV; i += 512) { const int tt = i / DV, ee = i % DV; const int t = dir ? (L - 1 - (rd * TB + tt)) : (rd * TB + tt); const size_t row = row0 + t;
            if (ssd) vs[tt * 128 + ee] = bf2f(XC[row * DM + h * 64 + ee]) * dta[((size_t)dir * 8 + h) * MTOK + row];
            else vs[tt * 128 + ee] = bf2f(PROJ[row * NPROJ + PV + h * 128 + ee]); }
        if (F.tid < TB) { const int t = dir ? (L - 1 - (rd * TB + F.tid)) : (rd * TB + F.tid); as_[F.tid] = ssd ? expf(dta[((size_t)(2 + dir) * 8 + h) * MTOK + row0 + t]) : a_const; }
        __syncthreads();
        float po[TB];
#pragma unroll
        for (int tt = 0; tt < TB; ++tt) { const float a = as_[tt], v = vs[tt * 128 + e]; float p = 0.f;
#pragma unroll
            for (int i = 0; i < ND; ++i) { const float q = qs[tt * 128 + d0 + i], k = ks[tt * 128 + d0 + i];
                const float sd = a * S[i]; const float sn = sd + k * v; p += q * (dir ? sd : sn); S[i] = sn; }
            po[tt] = p; }
#pragma unroll
        for (int tt = 0; tt < TB; ++tt) red[(dg * TB + tt) * DV + e] = po[tt];
        __syncthreads();
        for (int i = F.tid; i < TB * DV; i += 512) { const int tt = i / DV, ee = i % DV; float s = 0.f;
#pragma unroll
            for (int g = 0; g < NDG; ++g) s += red[(g * TB + tt) * DV + ee];
            const int t = dir ? (L - 1 - (rd * TB + tt)) : (rd * TB + tt);
            OF[(size_t)(row0 + t) * DM + (ssd ? 512 + h * 64 + ee : h * 128 + ee)] = (bf16)f2bf(s); }
    }
    (void)ocol;
    int e2 = e, d2 = d0; asm volatile("" : "+v"(e2), "+v"(d2));
    if (!lat) { float* dst = ssd ? F.out + OUT_SS + (((size_t)seq * 2 + dir) * 8 + h) * 8192 : F.out + OUT_SR + (((size_t)seq * 2 + dir) * 4 + h) * 16384;
#pragma unroll
        for (int i = 0; i < ND; ++i) dst[(size_t)(d2 + i) * DV + e2] = S[i]; }
}
__device__ __forceinline__ void p4_scan_slow(Frame& F) {
    constexpr int NU = 24 * 4 * 2 + 24 * 8 * 2;
    for (int u = F.vcu; u < NU; u += F.G) {
        int seq, h, dir; bool ssd;
        if (u < 64) { ssd = false; seq = 16 + u / 8; h = (u >> 1) & 3; dir = u & 1; }
        else if (u < 192) { const int v = u - 64; ssd = true; seq = 16 + v / 16; h = (v >> 1) & 7; dir = v & 1; }
        else if (u < 320) { const int v = u - 192; ssd = false; seq = v / 8; h = (v >> 1) & 3; dir = v & 1; }
        else { const int v = u - 320; ssd = true; seq = v / 16; h = (v >> 1) & 7; dir = v & 1; }
        if (ssd) p4_scan_unit<64>(F, seq, h, dir, true); else p4_scan_unit<128>(F, seq, h, dir, false);
        __syncthreads();
    }
}

__device__ __forceinline__ void p5_mixprep(Frame& F) {
    const bf16* PROJ = (const bf16*)(F.ws + WS_PROJ); const bf16* XC = (const bf16*)(F.ws + WS_XC);
    const bf16* OF = (const bf16*)(F.ws + WS_OF); const bf16* OB = OF + (size_t)MTOK * DM; bf16* A2 = (bf16*)(F.ws + WS_A2);
    const int gw = F.vcu * NWAVES + F.wave, NGW = F.G * NWAVES;
    for (int r = gw; r < MTOK; r += NGW) {
        {
            const int c0 = 8 * F.lane;
            const v4u f = *(const v4u*)(OF + (size_t)r * DM + c0), b = *(const v4u*)(OB + (size_t)r * DM + c0), g = *(const v4u*)(PROJ + (size_t)r * NPROJ + PG + c0);
            float o[8] = { bflo(f.x) + bflo(b.x), bfhi(f.x) + bfhi(b.x), bflo(f.y) + bflo(b.y), bfhi(f.y) + bfhi(b.y), bflo(f.z) + bflo(b.z), bfhi(f.z) + bfhi(b.z), bflo(f.w) + bflo(b.w), bfhi(f.w) + bfhi(b.w) };
            float ss = 0.f;
#pragma unroll
            for (int e = 0; e < 8; ++e) ss += o[e] * o[e];
#pragma unroll
            for (int m = 1; m < 16; m <<= 1) ss += __shfl_xor(ss, m);
            const float rs = 1.0f / sqrtf(ss * (1.0f / 128.0f) + LN_EPS);
            const float gg[8] = { bflo(g.x), bfhi(g.x), bflo(g.y), bfhi(g.y), bflo(g.z), bfhi(g.z), bflo(g.w), bfhi(g.w) };
            v4u w; w.x = pk2(siluf(gg[0]) * o[0] * rs, siluf(gg[1]) * o[1] * rs); w.y = pk2(siluf(gg[2]) * o[2] * rs, siluf(gg[3]) * o[3] * rs);
            w.z = pk2(siluf(gg[4]) * o[4] * rs, siluf(gg[5]) * o[5] * rs); w.w = pk2(siluf(gg[6]) * o[6] * rs, siluf(gg[7]) * o[7] * rs);
            *(v4u*)(A2 + (size_t)r * DM + c0) = w; }
        {
            const int c0 = 8 * F.lane; const float dsk = F.in[15][F.lane >> 3];
            const v4u f = *(const v4u*)(OF + (size_t)r * DM + 512 + c0), b = *(const v4u*)(OB + (size_t)r * DM + 512 + c0);
            const v4u z = *(const v4u*)(PROJ + (size_t)r * NPROJ + PZ + c0), x = *(const v4u*)(XC + (size_t)r * DM + c0);
            const float zz[8] = { bflo(z.x), bfhi(z.x), bflo(z.y), bfhi(z.y), bflo(z.z), bfhi(z.z), bflo(z.w), bfhi(z.w) };
            const float xx[8] = { bflo(x.x), bfhi(x.x), bflo(x.y), bfhi(x.y), bflo(x.z), bfhi(x.z), bflo(x.w), bfhi(x.w) };
            float y[8] = { bflo(f.x) + bflo(b.x), bfhi(f.x) + bfhi(b.x), bflo(f.y) + bflo(b.y), bfhi(f.y) + bfhi(b.y), bflo(f.z) + bflo(b.z), bfhi(f.z) + bfhi(b.z), bflo(f.w) + bflo(b.w), bfhi(f.w) + bfhi(b.w) };
            float ss = 0.f;
#pragma unroll
            for (int e = 0; e < 8; ++e) { y[e] = (y[e] + dsk * xx[e]) * siluf(zz[e]); ss += y[e] * y[e]; }
            ss = wave_sum(ss);
            const float rs = 1.0f / sqrtf(ss * (1.0f / 512.0f) + LN_EPS); const float* nw = F.in[16] + c0;
            v4u w; w.x = pk2(y[0] * rs * nw[0], y[1] * rs * nw[1]); w.y = pk2(y[2] * rs * nw[2], y[3] * rs * nw[3]); w.z = pk2(y[4] * rs * nw[4], y[5] * rs * nw[5]); w.w = pk2(y[6] * rs * nw[6], y[7] * rs * nw[7]);
            *(v4u*)(A2 + (size_t)r * DM + 512 + c0) = w; }
    }
}

template <bool MAKE_H> __device__ __forceinline__ void ln_rows(Frame& F, const float* T, const float* g, const float* b, float* Y, bf16* H, int sh_off) {
    const float* mod = (const float*)(F.ws + WS_MOD);
    const int gw = F.vcu * NWAVES + F.wave, NGW = F.G * NWAVES;
    for (int r = gw; r < MTOK; r += NGW) {
        const float* tr = T + (size_t)r * DM; f32x4 v[4]; float s = 0.f;
#pragma unroll
        for (int q = 0; q < 4; ++q) { v[q] = *(const f32x4*)(tr + 4 * F.lane + 256 * q); s += (v[q][0] + v[q][1]) + (v[q][2] + v[q][3]); }
        const float mean = wave_sum(s) * (1.f / DM); float s2 = 0.f;
#pragma unroll
        for (int q = 0; q < 4; ++q) { v[q] = v[q] - mean; s2 += (v[q][0] * v[q][0] + v[q][1] * v[q][1]) + (v[q][2] * v[q][2] + v[q][3] * v[q][3]); }
        const float rstd = 1.f / sqrtf(wave_sum(s2) * (1.f / DM) + LN_EPS);
        const float* md = mod + (size_t)cond_of_row(r) * 6144;
#pragma unroll
        for (int q = 0; q < 4; ++q) { const int col = 4 * F.lane + 256 * q;
            const f32x4 y = v[q] * rstd * *(const f32x4*)(g + col) + *(const f32x4*)(b + col);
            *(f32x4*)(Y + (size_t)r * DM + col) = y;
            if (MAKE_H) { const f32x4 h = y * (*(const f32x4*)(md + sh_off + 1024 + col) + 1.0f) + *(const f32x4*)(md + sh_off + col);
                v2u o; o.x = pk2(h[0], h[1]); o.y = pk2(h[2], h[3]); *(v2u*)(H + (size_t)r * DM + col) = o; } }
    }
}

__global__ void __launch_bounds__(NWAVES * 64, 2) mk_fwd(Args args) {
    extern __shared__ __attribute__((aligned(16))) unsigned char lds[];
    Frame F;
    F.lds = (LAS unsigned char*)lds; F.MISC = (volatile LAS unsigned*)(F.lds + MISC_OFF);
    F.wave = __builtin_amdgcn_readfirstlane(threadIdx.x >> 6); F.lane = (int)__builtin_amdgcn_mbcnt_hi(~0u, __builtin_amdgcn_mbcnt_lo(~0u, 0u)); F.tid = F.wave * 64 + F.lane;
    F.G = gridDim.x; { const int bx = blockIdx.x; F.vcu = (F.G % 8 == 0) ? (bx % 8) * (F.G / 8) + bx / 8 : bx; }
    F.in = args.in; F.out = args.out; F.ws = args.ws; F.ctl = (gu32*)(args.ws + WS_CTL);
    for (int u = F.tid; u < (LDS_BYTES - LDSCTL_OFF) / 4; u += NWAVES * 64) ((LAS unsigned*)(F.lds + LDSCTL_OFF))[u] = 0u;
    __syncthreads();
    XcdBarrier bar; bar.bar = (unsigned*)(F.ctl + CW_BAR); bar.x = 0; bar.st = nullptr;
    if (!MK_PER_PHASE) bar = xcd_barrier_post((unsigned*)(F.ctl + CW_BAR), F.MISC + 8);
    const int lo = args.ph_lo, hi = args.ph_hi;
#define IN(k) (lo <= (k) && (k) < hi)
#define SEAM(k) do { if (IN(k) && IN((k) + 1)) xcd_barrier(bar); } while (0)
    unsigned char* ws = args.ws;
    if (IN(0)) { p0_prologue(F); SEAM(0); }
    if (IN(1)) { p1_hprep(F); SEAM(1); }
    if (IN(2)) {
        pg8::Gemm g{(const pg8::bf16_t*)(ws + WS_H1), (const pg8::bf16_t*)(ws + WS_WIN), MTOK, NPROJ, DM}; pg8::StaticOrder S; S.init(MTOK, NPROJ, F.G, (int)blockIdx.x);
        pg8::EpiIn E{(pg8::bf16_t*)(ws + WS_PROJ), (const float*)(ws + WS_ROPE)};
        pg8::gemm_phase<pg8::EpiIn, pg8::StaticOrder, true, true>(F.lds + RING_OFF, g, S, E);
        SEAM(2);
    }
    if (IN(3)) { p3_conv(F); SEAM(3); }
    if (IN(4)) { p4_scan_slow(F); SEAM(4); }
    if (IN(5)) { p5_mixprep(F); SEAM(5); }
    if (IN(6)) {
        pg8::Gemm g{(const pg8::bf16_t*)(ws + WS_A2), (const pg8::bf16_t*)(ws + WS_WOUT), MTOK, DM, DM}; pg8::StaticOrder S; S.init(MTOK, DM, F.G, (int)blockIdx.x);
        pg8::EpiRes E{(float*)(ws + WS_T1), F.in[0], F.in[1], (const float*)(ws + WS_MOD) + 2048, ALPHA};
        pg8::gemm_phase<pg8::EpiRes, pg8::StaticOrder, true, true>(F.lds + RING_OFF, g, S, E);
        SEAM(6);
    }
    if (IN(7)) { ln_rows<true>(F, (const float*)(ws + WS_T1), F.in[18], F.in[19], F.out, (bf16*)(ws + WS_H2), 3072); SEAM(7); }
    if (IN(8)) {
        pg8::Gemm g{(const pg8::bf16_t*)(ws + WS_H2), (const pg8::bf16_t*)(ws + WS_WGU), MTOK, NGU, DM}; pg8::StaticOrder S; S.init(MTOK, NGU, F.G, (int)blockIdx.x);
        pg8::EpiGU E{(pg8::bf16_t*)(ws + WS_ACT)};
        pg8::gemm_phase<pg8::EpiGU, pg8::StaticOrder, true, true>(F.lds + RING_OFF, g, S, E);
        SEAM(8);
    }
    if (IN(9)) {
        pg8::Gemm g{(const pg8::bf16_t*)(ws + WS_ACT), (const pg8::bf16_t*)(ws + WS_WD), MTOK, DM, DFF}; pg8::StaticOrder S; S.init(MTOK, DM, F.G, (int)blockIdx.x);
        pg8::EpiRes E{(float*)(ws + WS_T2), F.out, F.out + (size_t)NCTX * DM, (const float*)(ws + WS_MOD) + 5120, ALPHA};
        pg8::gemm_phase<pg8::EpiRes, pg8::StaticOrder, true, true>(F.lds + RING_OFF, g, S, E);
        SEAM(9);
    }
    if (IN(10)) { ln_rows<false>(F, (const float*)(ws + WS_T2), F.in[23], F.in[24], F.out, nullptr, 0); }
#undef IN
#undef SEAM
}

extern "C" void kernel_launch(void* const* d_in, const int* in_sizes, int n_in, void* d_out, int out_size, void* d_ws, size_t ws_size, hipStream_t stream) {
    static int grid = 0;
    if (grid == 0) {
        if (n_in != 27 || out_size != 16777216 || ws_size < WS_END) { fprintf(stderr, "kernel_launch: unexpected shapes (n_in %d, out %d, ws %zu); nothing launched\n", n_in, out_size, ws_size); grid = -1; return; }
        int dev = 0, cus = 0, per_cu = 0;
        if (hipGetDevice(&dev) != hipSuccess || hipDeviceGetAttribute(&cus, hipDeviceAttributeMultiprocessorCount, dev) != hipSuccess) { grid = -1; return; }
        if (hipFuncSetAttribute((const void*)mk_fwd, hipFuncAttributeMaxDynamicSharedMemorySize, LDS_BYTES) != hipSuccess) { fprintf(stderr, "kernel_launch: hipFuncSetAttribute failed\n"); grid = -1; return; }
        if (hipOccupancyMaxActiveBlocksPerMultiprocessor(&per_cu, (const void*)mk_fwd, NWAVES * 64, LDS_BYTES) != hipSuccess || per_cu < 1) fprintf(stderr, "kernel_launch: note: occupancy query reports %d\n", per_cu);
        (void)hipGetLastError();
        grid = cus;
    }
    if (grid < 0) return;
    if (hipMemsetAsync((char*)d_ws + WS_CTL, 0, CTL_ZERO_BYTES, stream) != hipSuccess) return;
    Args a{};
    for (int i = 0; i < 27; ++i) a.in[i] = (const float*)d_in[i];
    a.out = (float*)d_out; a.ws = (unsigned char*)d_ws;
#if MK_PER_PHASE
    for (int p = 0; p < N_PHASES; ++p) { a.ph_lo = p; a.ph_hi = p + 1; hipLaunchKernelGGL(mk_fwd, dim3(grid), dim3(NWAVES * 64), LDS_BYTES, stream, a); }
#else
    a.ph_lo = 0; a.ph_hi = N_PHASES; hipLaunchKernelGGL(mk_fwd, dim3(grid), dim3(NWAVES * 64), LDS_BYTES, stream, a);
#endif
}
```

```cpp
#include <hip/hip_runtime.h>
#include <cstdio>
#include <cstdint>
namespace pg8 {
#define PG8_LAS __attribute__((address_space(3)))
typedef unsigned short bf16_t;
typedef short bf16x8 __attribute__((ext_vector_type(8)));
typedef float f32x4 __attribute__((ext_vector_type(4)));
typedef unsigned u32x4 __attribute__((ext_vector_type(4)));
constexpr int BM = 256, BK = 64, HALF = 128, HTB = HALF * BK * 2  , STAGE_BYTES = 8 * HTB, NXCD = 8, WGM = 8;

__host__ __device__ __forceinline__ int lds_byte(int r, int c) { const int st = (r >> 4) * 2 + (c >> 5), rr = r & 15, cc = c & 31, ob = rr * 64 + cc * 2; return st * 1024 + (ob ^ (((ob >> 9) & 1) << 5)); }
__host__ __device__ __forceinline__ void stage_rc(int b, int& R, int& C) { const int st = b / 1024, sb = b % 1024, swz = sb ^ (((sb >> 9) & 1) << 5); R = (st >> 1) * 16 + swz / 64; C = (st & 1) * 32 + (swz % 64) / 2; }
__host__ __device__ __forceinline__ int perm32(int rho) { const int n = rho >> 4, i = rho & 15; return 8 * (i >> 2) + 4 * n + (i & 3); }

struct Unit { int pm, pn; };
struct Gemm { const bf16_t* A; const bf16_t* Bt; int M, N, K; };

struct StaticOrder {
    int nM, nN, nwg, G, c;
    __host__ __device__ void init(int M, int N, int G_, int c_) { nM = M / BM; nN = N / BM; nwg = nM * nN; G = G_; c = c_; }
    __host__ __device__ bool next(int i, Unit& u) const {
        const long L = (long)i * G + c; if (L >= nwg) return false;
        int wgid = (int)L; { const int q = nwg / NXCD, r = nwg % NXCD, xcd = wgid % NXCD, off = wgid / NXCD; wgid = (xcd < r ? xcd * (q + 1) : r * (q + 1) + (xcd - r) * q) + off; }
        const int nig = WGM * nN, gid = wgid / nig, fm = gid * WGM, gsz = (nM - fm) < WGM ? (nM - fm) : WGM;
        u.pm = fm + ((wgid % nig) % gsz); u.pn = (wgid % nig) / gsz; return true;
    }
    __device__ __forceinline__ void a_ready(const Unit&) const {}
    __device__ __forceinline__ void done(const Unit&) const {}
};

__device__ __forceinline__ unsigned cvt_pk_bf16(float lo, float hi) { unsigned r; asm volatile("v_cvt_pk_bf16_f32 %0, %1, %2" : "=v"(r) : "v"(lo), "v"(hi)); return r; }
typedef unsigned u32x2 __attribute__((ext_vector_type(2)));
__device__ __forceinline__ float silu_f(float x) { return x / (1.0f + __expf(-x)); }

struct EpiIn {
    static constexpr bool PERM = false, AFTER_DRAIN = false;
    bf16_t* P; const float* rope;
    __device__ __forceinline__ void operator()(const f32x4 (&acc)[2][2][4][2], const Unit& u, int wr, int wc, int fr, int fq) const {
        const int row0 = u.pm * BM + wr * 64 + fr;
        if (u.pn < 4) {
            const bool lat = u.pm >= 16; const float ksc = (u.pn >= 2) ? 0.08838834764831845f : 1.0f;
            const int i0 = 16 * wc + 4 * fq;
#pragma unroll
            for (int ai = 0; ai < 2; ++ai)
#pragma unroll
                for (int m = 0; m < 4; ++m) {
                    const int row = row0 + ai * HALF + m * 16;
                    f32x4 cs0 = (f32x4){1.f, 0.f, 1.f, 0.f}, cs1 = cs0;
                    if (lat) { const int t = (row - 4096) & 1023; const int pos = (wc < 2) ? (t >> 6) : (t & 63); const float* rp = rope + ((size_t)pos * 32 + (i0 & 31)) * 2; cs0 = *(const f32x4*)rp; cs1 = *(const f32x4*)(rp + 4); }
                    bf16_t* rowp = P + (size_t)row * 3584 + u.pn * BM + i0;
#pragma unroll
                    for (int bj = 0; bj < 2; ++bj) {
                        const f32x4 x1 = acc[ai][bj][m][0], x2 = acc[ai][bj][m][1];
                        f32x4 y1, y2;
                        y1[0] = (x1[0] * cs0[0] - x2[0] * cs0[1]) * ksc; y2[0] = (x1[0] * cs0[1] + x2[0] * cs0[0]) * ksc;
                        y1[1] = (x1[1] * cs0[2] - x2[1] * cs0[3]) * ksc; y2[1] = (x1[1] * cs0[3] + x2[1] * cs0[2]) * ksc;
                        y1[2] = (x1[2] * cs1[0] - x2[2] * cs1[1]) * ksc; y2[2] = (x1[2] * cs1[1] + x2[2] * cs1[0]) * ksc;
                        y1[3] = (x1[3] * cs1[2] - x2[3] * cs1[3]) * ksc; y2[3] = (x1[3] * cs1[3] + x2[3] * cs1[2]) * ksc;
                        u32x2 w1, w2; w1.x = cvt_pk_bf16(y1[0], y1[1]); w1.y = cvt_pk_bf16(y1[2], y1[3]); w2.x = cvt_pk_bf16(y2[0], y2[1]); w2.y = cvt_pk_bf16(y2[2], y2[3]);
                        *(u32x2*)(rowp + bj * HALF) = w1; *(u32x2*)(rowp + bj * HALF + 64) = w2;
                    }
                }
        } else {
            const int col0 = u.pn * BM + wc * 32 + 8 * fq;
#pragma unroll
            for (int ai = 0; ai < 2; ++ai)
#pragma unroll
                for (int m = 0; m < 4; ++m) { bf16_t* rowp = P + (size_t)(row0 + ai * HALF + m * 16) * 3584 + col0;
#pragma unroll
                    for (int bj = 0; bj < 2; ++bj) { const f32x4 v0 = acc[ai][bj][m][0], v1 = acc[ai][bj][m][1];
                        u32x4 w; w.x = cvt_pk_bf16(v0[0], v0[1]); w.y = cvt_pk_bf16(v0[2], v0[3]); w.z = cvt_pk_bf16(v1[0], v1[1]); w.w = cvt_pk_bf16(v1[2], v1[3]);
                        *(u32x4*)(rowp + bj * HALF) = w; } }
        }
    }
};
struct EpiRes {
    static constexpr bool PERM = false, AFTER_DRAIN = false;
    float* T; const float* base0; const float* base1; const float* gate  ; float alpha;
    __device__ __forceinline__ void operator()(const f32x4 (&acc)[2][2][4][2], const Unit& u, int wr, int wc, int fr, int fq) const {
        const int row0 = u.pm * BM + wr * 64 + fr, col0 = u.pn * BM + wc * 32 + 4 * fq;
        const int cond = (u.pm < 16) ? 0 : 1 + ((u.pm - 16) >> 2);
        const float* bs = (u.pm < 16) ? base0 : base1 - (size_t)4096 * 1024;
        const float* gp = gate + (size_t)cond * 6144 + col0;
        f32x4 gv[2][2];
#pragma unroll
        for (int bj = 0; bj < 2; ++bj)
#pragma unroll
            for (int n = 0; n < 2; ++n) gv[bj][n] = *(const f32x4*)(gp + bj * HALF + n * 16);
#pragma unroll
        for (int ai = 0; ai < 2; ++ai)
#pragma unroll
            for (int m = 0; m < 4; ++m) { const size_t off = (size_t)(row0 + ai * HALF + m * 16) * 1024 + col0;
#pragma unroll
                for (int bj = 0; bj < 2; ++bj)
#pragma unroll
                    for (int n = 0; n < 2; ++n) { const f32x4 b = *(const f32x4*)(bs + off + bj * HALF + n * 16); *(f32x4*)(T + off + bj * HALF + n * 16) = b * alpha + gv[bj][n] * acc[ai][bj][m][n]; } }
    }
};
struct EpiGU {
    static constexpr bool PERM = false, AFTER_DRAIN = false;
    bf16_t* ACT;
    __device__ __forceinline__ void operator()(const f32x4 (&acc)[2][2][4][2], const Unit& u, int wr, int wc, int fr, int fq) const {
        const int row0 = u.pm * BM + wr * 64 + fr, col0 = u.pn * HALF + wc * 32 + 8 * fq;
#pragma unroll
        for (int ai = 0; ai < 2; ++ai)
#pragma unroll
            for (int m = 0; m < 4; ++m) { bf16_t* rowp = ACT + (size_t)(row0 + ai * HALF + m * 16) * 2816 + col0;
                f32x4 v0, v1;
#pragma unroll
                for (int e = 0; e < 4; ++e) { v0[e] = silu_f(acc[ai][0][m][0][e]) * acc[ai][1][m][0][e]; v1[e] = silu_f(acc[ai][0][m][1][e]) * acc[ai][1][m][1][e]; }
                u32x4 w; w.x = cvt_pk_bf16(v0[0], v0[1]); w.y = cvt_pk_bf16(v0[2], v0[3]); w.z = cvt_pk_bf16(v1[0], v1[1]); w.w = cvt_pk_bf16(v1[2], v1[3]);
                *(u32x4*)rowp = w; }
    }
};

template <class Epi, class Sched, bool ALIGN_EPI = false, bool SP2 = false>
__device__ __forceinline__ void gemm_phase(PG8_LAS unsigned char* lds, const Gemm g, const Sched& S, const Epi& E) {
    const int tid = threadIdx.x, wid = __builtin_amdgcn_readfirstlane(tid >> 6), lane = tid & 63, wr = wid >> 2, wc = wid & 3, fr = lane & 15, fq = lane >> 4;
    const int K = g.K, nt = K / BK;
    unsigned voffA[2], voffB[2];
#pragma unroll
    for (int i = 0; i < 2; ++i) { int R, C; stage_rc(tid * 16 + i * 8192, R, C); const int Rb = Epi::PERM ? ((R & ~31) + perm32(R & 31)) : R;
        voffA[i] = (unsigned)(R * K + C) * 2u; voffB[i] = (unsigned)(Rb * K + C) * 2u; }
    const size_t kstep = (size_t)(BK * 2);
    const size_t hstep = (size_t)HALF * K * 2;
    const size_t tstep = 2 * hstep;
    const unsigned ldsw = (unsigned)wid * 1024u;
    const int aoff = lds_byte(wr * 64 + fr, fq * 8), boff = lds_byte(wc * 32 + fr, fq * 8);
#define PG8_SA(b, h) (((b) * 2 + (h)) * HTB)
#define PG8_SB(b, h) ((4 + (b) * 2 + (h)) * HTB)
#define PG8_STAGE(bufoff, gbase, voff) do { _Pragma("unroll") for (int _i = 0; _i < 2; ++_i) \
        __builtin_amdgcn_global_load_lds((const unsigned*)((const char*)(gbase) + (voff)[_i]), (PG8_LAS unsigned*)(lds + (bufoff) + ldsw + _i * 8192), 16, 0, 0); } while (0)
#define PG8_LDA(dst, b, h) do { _Pragma("unroll") for (int m = 0; m < 4; ++m) _Pragma("unroll") for (int k = 0; k < 2; ++k) dst[m][k] = *(const PG8_LAS bf16x8*)(lds + PG8_SA(b, h) + aoff + m * 2048 + k * 1024); } while (0)
#define PG8_LDB(dst, b, h) do { _Pragma("unroll") for (int n = 0; n < 2; ++n) _Pragma("unroll") for (int k = 0; k < 2; ++k) dst[n][k] = *(const PG8_LAS bf16x8*)(lds + PG8_SB(b, h) + boff + n * 2048 + k * 1024); } while (0)
#define PG8_MMA(ai, bj, At, Bt) do { __builtin_amdgcn_s_setprio(1); _Pragma("unroll") for (int m = 0; m < 4; ++m) _Pragma("unroll") for (int n = 0; n < 2; ++n) _Pragma("unroll") for (int k = 0; k < 2; ++k) \
        acc[ai][bj][m][n] = __builtin_amdgcn_mfma_f32_16x16x32_bf16(Bt[n][k], At[m][k], acc[ai][bj][m][n], 0, 0, 0); __builtin_amdgcn_s_setprio(0); } while (0)
#define PG8_WAIT_V(n) asm volatile("s_waitcnt vmcnt(" #n ")" ::: "memory")
#define PG8_WAIT_L(n) asm volatile("s_waitcnt lgkmcnt(" #n ")" ::: "memory")
#define PG8_BAR __builtin_amdgcn_s_barrier()
#define PG8_SCHED __builtin_amdgcn_sched_barrier(0)
    Unit cur, nxt; int ui = 0;
    if (!S.next(0, cur)) return;
    f32x4 acc[2][2][4][2];
#pragma unroll
    for (int a = 0; a < 2; ++a)
#pragma unroll
        for (int b = 0; b < 2; ++b)
#pragma unroll
            for (int m = 0; m < 4; ++m)
#pragma unroll
                for (int n = 0; n < 2; ++n) acc[a][b][m][n] = (f32x4){0.f, 0.f, 0.f, 0.f};
    bf16x8 At[4][2], B0[2][2], B1[2][2];
    const char* cA = (const char*)g.A + (size_t)cur.pm * tstep; const char* cB = (const char*)g.Bt + (size_t)cur.pn * tstep;
    S.a_ready(cur);
    if constexpr (SP2) {
        PG8_STAGE(PG8_SB(0, 0), cB, voffB); PG8_STAGE(PG8_SB(0, 1), cB + hstep, voffB); PG8_STAGE(PG8_SA(0, 0), cA, voffA); PG8_STAGE(PG8_SA(0, 1), cA + hstep, voffA);
        if (wr == 1) PG8_BAR;
        PG8_WAIT_V(2); PG8_BAR;
        PG8_STAGE(PG8_SB(1, 0), cB + kstep, voffB); PG8_STAGE(PG8_SA(1, 0), cA + kstep, voffA); PG8_STAGE(PG8_SB(1, 1), cB + hstep + kstep, voffB);
        PG8_WAIT_V(6); PG8_BAR;
    } else {
        PG8_STAGE(PG8_SB(0, 0), cB, voffB); PG8_STAGE(PG8_SA(0, 0), cA, voffA); PG8_STAGE(PG8_SB(0, 1), cB + hstep, voffB); PG8_STAGE(PG8_SA(0, 1), cA + hstep, voffA);
        if (wr == 1) PG8_BAR;
        PG8_WAIT_V(4); PG8_BAR;
        PG8_STAGE(PG8_SB(1, 0), cB + kstep, voffB); PG8_STAGE(PG8_SA(1, 0), cA + kstep, voffA); PG8_STAGE(PG8_SB(1, 1), cB + hstep + kstep, voffB);
        PG8_WAIT_V(6); PG8_BAR;
    }
    for (;;) {
        const bool has_next = S.next(ui + 1, nxt);
        const char* nA = has_next ? (const char*)g.A + (size_t)nxt.pm * tstep : cA; const char* nB = has_next ? (const char*)g.Bt + (size_t)nxt.pn * tstep : cB;
        for (int t = 0; t < nt; t += 2) {
            const bool last = (t == nt - 2);
            const char* a1 = cA + (size_t)(t + 1) * kstep;
            const char* a2 = last ? nA : cA + (size_t)(t + 2) * kstep; const char* b2 = last ? nB : cB + (size_t)(t + 2) * kstep;
            const char* a3 = a2 + kstep; const char* b3 = b2 + kstep;
            if (last && has_next) S.a_ready(nxt);
            if constexpr (SP2) {
            PG8_LDB(B0, 0, 0); PG8_LDB(B1, 0, 1); PG8_SCHED; PG8_LDA(At, 0, 0); PG8_STAGE(PG8_SA(1, 1), a1 + hstep, voffA);
            PG8_WAIT_V(8); PG8_WAIT_L(0); PG8_BAR; PG8_MMA(0, 0, At, B0); PG8_MMA(0, 1, At, B1); PG8_BAR; PG8_SCHED;
            PG8_LDA(At, 0, 1); PG8_STAGE(PG8_SB(0, 0), b2, voffB); PG8_STAGE(PG8_SB(0, 1), b2 + hstep, voffB); PG8_STAGE(PG8_SA(0, 0), a2, voffA);
            PG8_WAIT_V(8); PG8_WAIT_L(0); PG8_BAR; PG8_MMA(1, 0, At, B0); PG8_MMA(1, 1, At, B1); PG8_BAR; PG8_SCHED;
            PG8_LDB(B0, 1, 0); PG8_LDB(B1, 1, 1); PG8_SCHED; PG8_LDA(At, 1, 0); PG8_STAGE(PG8_SA(0, 1), a2 + hstep, voffA);
            PG8_WAIT_V(8); PG8_WAIT_L(0); PG8_BAR; PG8_MMA(0, 0, At, B0); PG8_MMA(0, 1, At, B1); PG8_BAR; PG8_SCHED;
            PG8_LDA(At, 1, 1); PG8_STAGE(PG8_SB(1, 0), b3, voffB); PG8_STAGE(PG8_SB(1, 1), b3 + hstep, voffB); PG8_STAGE(PG8_SA(1, 0), a3, voffA);
            PG8_WAIT_V(8); PG8_WAIT_L(0); PG8_BAR; PG8_MMA(1, 0, At, B0); PG8_MMA(1, 1, At, B1); PG8_BAR; PG8_SCHED;
            } else {
            PG8_LDB(B0, 0, 0); PG8_SCHED; PG8_LDA(At, 0, 0); PG8_STAGE(PG8_SA(1, 1), a1 + hstep, voffA);
            PG8_WAIT_L(8); PG8_BAR; PG8_WAIT_L(0); PG8_MMA(0, 0, At, B0); PG8_BAR; PG8_SCHED;
            PG8_LDB(B1, 0, 1); PG8_STAGE(PG8_SB(0, 0), b2, voffB);
            PG8_BAR; PG8_WAIT_L(0); PG8_MMA(0, 1, At, B1); PG8_BAR;
            PG8_LDA(At, 0, 1); PG8_STAGE(PG8_SA(0, 0), a2, voffA);
            PG8_BAR; PG8_WAIT_L(0); PG8_MMA(1, 0, At, B0); PG8_BAR; PG8_SCHED;
            PG8_STAGE(PG8_SB(0, 1), b2 + hstep, voffB);
            PG8_WAIT_V(6); PG8_BAR; PG8_MMA(1, 1, At, B1); PG8_BAR;
            PG8_LDB(B0, 1, 0); PG8_SCHED; PG8_LDA(At, 1, 0); PG8_STAGE(PG8_SA(0, 1), a2 + hstep, voffA);
            PG8_WAIT_L(8); PG8_BAR; PG8_WAIT_L(0); PG8_MMA(0, 0, At, B0); PG8_BAR; PG8_SCHED;
            PG8_LDB(B1, 1, 1); PG8_STAGE(PG8_SB(1, 0), b3, voffB);
            PG8_BAR; PG8_WAIT_L(0); PG8_MMA(0, 1, At, B1); PG8_BAR;
            PG8_LDA(At, 1, 1); PG8_STAGE(PG8_SA(1, 0), a3, voffA);
            PG8_BAR; PG8_WAIT_L(0); PG8_MMA(1, 0, At, B0); PG8_BAR; PG8_SCHED;
            PG8_STAGE(PG8_SB(1, 1), b3 + hstep, voffB);
            PG8_WAIT_V(6); PG8_BAR; PG8_MMA(1, 1, At, B1); PG8_BAR;
            }
        }
        if constexpr (ALIGN_EPI) { if (wr == 0) PG8_BAR; }
        if constexpr (!Epi::AFTER_DRAIN) { E(acc, cur, wr, wc, fr, fq); S.done(cur); }
        if (!has_next) break;
#pragma unroll
        for (int a = 0; a < 2; ++a)
#pragma unroll
            for (int b = 0; b < 2; ++b)
#pragma unroll
                for (int m = 0; m < 4; ++m)
#pragma unroll
                    for (int n = 0; n < 2; ++n) acc[a][b][m][n] = (f32x4){0.f, 0.f, 0.f, 0.f};
        cur = nxt; cA = nA; cB = nB; ++ui;
        if constexpr (ALIGN_EPI) { if (wr == 1) PG8_BAR; }
    }
    PG8_WAIT_V(0);
    if constexpr (!ALIGN_EPI) { if (wr == 0) PG8_BAR; }
    PG8_BAR;
    if constexpr (Epi::AFTER_DRAIN) { E.fused(acc, cur, wr, wc, fr, fq, lds, wid, lane); S.done(cur); }
#undef PG8_SA
#undef PG8_SB
#undef PG8_STAGE
#undef PG8_LDA
#undef PG8_LDB
#undef PG8_MMA
#undef PG8_WAIT_V
#undef PG8_WAIT_L
#undef PG8_BAR
#undef PG8_SCHED
}
}

constexpr int NWAVES = 8;
#ifndef MK_PER_PHASE
#define MK_PER_PHASE 0
#endif
constexpr int N_PHASES = 11;

constexpr int DM = 1024, NCTX = 4096, NLAT = 8192, MTOK = NCTX + NLAT, NPROJ = 3584, INCOLS = 3592, DFF = 2816, NGU = 2 * DFF;
constexpr int PQ = 0, PK = 512, PV = 1024, PG = 1536, PZ = 2048, PX = 2560;
constexpr float LN_EPS = 1e-6f, ALPHA = 1.189207115002721f;
constexpr size_t OUT_SR = (size_t)MTOK * DM, OUT_SS = OUT_SR + (size_t)16 * 2 * 4 * 128 * 128;

constexpr size_t MiB = 1u << 20;
constexpr size_t WS_CTL = 0, CTL_ZERO_BYTES = 1 * MiB;
constexpr size_t WS_MOD = 1 * MiB;
constexpr size_t WS_ROPE = 1 * MiB + 512 * 1024;
constexpr size_t WS_DTA = 2 * MiB;
constexpr size_t WS_DTRAW = 4 * MiB;
constexpr size_t WS_WIN = 5 * MiB, WS_WOUT = 13 * MiB, WS_WGU = 15 * MiB, WS_WD = 27 * MiB;
constexpr size_t WS_PROJ = 34 * MiB;
constexpr size_t WS_H1 = 118 * MiB, WS_XC = 118 * MiB;
constexpr size_t WS_OF = 142 * MiB;
constexpr size_t WS_A2 = 190 * MiB;
constexpr size_t WS_T1 = 34 * MiB;
constexpr size_t WS_H2 = 82 * MiB;
constexpr size_t WS_ACT = 118 * MiB;
constexpr size_t WS_T2 = 34 * MiB;
constexpr size_t WS_END = 214 * MiB;
constexpr int CW_TMO = 0, CW_BAR = 4096;

constexpr int RING_OFF = 0, RING_BYTES = 131072;
constexpr int LDSCTL_OFF = RING_BYTES, MISC_OFF = LDSCTL_OFF + 320;
constexpr int LDS_BYTES = 147456;

#define GAS __attribute__((address_space(1)))
#define LAS __attribute__((address_space(3)))
typedef unsigned short bf16;
typedef unsigned v4u __attribute__((ext_vector_type(4)));
typedef unsigned v2u __attribute__((ext_vector_type(2)));
typedef float f32x4 __attribute__((ext_vector_type(4)));
typedef GAS unsigned gu32;
#define RLX_AGENT __ATOMIC_RELAXED, __HIP_MEMORY_SCOPE_AGENT
#define LDS_WAIT() asm volatile("s_waitcnt lgkmcnt(0)" ::: "memory")
#define VM_WAIT() asm volatile("s_waitcnt vmcnt(0)" ::: "memory")
__device__ __forceinline__ unsigned f2bf(float f) { unsigned u = __builtin_bit_cast(unsigned, f); return (u + 0x7fffu + ((u >> 16) & 1u)) >> 16; }
__device__ __forceinline__ unsigned pk2(float lo, float hi) { return f2bf(lo) | (f2bf(hi) << 16); }
__device__ __forceinline__ float bf2f(unsigned short b) { return __builtin_bit_cast(float, (unsigned)b << 16); }
__device__ __forceinline__ float bflo(unsigned w) { return __builtin_bit_cast(float, w << 16); }
__device__ __forceinline__ float bfhi(unsigned w) { return __builtin_bit_cast(float, w & 0xffff0000u); }
__device__ __forceinline__ float siluf(float x) { return x / (1.0f + __expf(-x)); }
__device__ __forceinline__ float softplusf(float x) { return x > 20.f ? x : log1pf(expf(x)); }
__device__ __forceinline__ float wave_sum(float v) {
#pragma unroll
    for (int o = 1; o < 64; o <<= 1) v += __shfl_xor(v, o);
    return v;
}
#define XB_TMO      128
#define XB_XCNT(j)  (256  + 64 * (j))
#define XB_XSUB(j)  (1280 + 64 * (j))
#define XB_XGEN(j)  (2304 + 64 * (j))
#define XB_TOP      3328
#define XB_TOPGEN   3392
#define XCD_BAR_WORDS 3456
#define XB_SPIN_CAP (1u << 18)

__device__ __forceinline__ unsigned xb_ld(unsigned* p)              { return __hip_atomic_load(p, __ATOMIC_RELAXED, __HIP_MEMORY_SCOPE_AGENT); }
__device__ __forceinline__ unsigned xb_add(unsigned* p, unsigned v) { return __hip_atomic_fetch_add(p, v, __ATOMIC_RELAXED, __HIP_MEMORY_SCOPE_AGENT); }
__device__ __forceinline__ unsigned xb_xcc_id() { return (unsigned)__builtin_amdgcn_s_getreg((3 << 11) | 20) & 0xFu; }
#define XB_SPIN(cond, bar) do { unsigned _sp = 0; while (cond) { __builtin_amdgcn_s_sleep(1); \
    if ((++_sp & 255u) == 0u) { if (xb_ld(&(bar)[XB_TMO])) break; if (_sp > XB_SPIN_CAP) { atomicAdd(&(bar)[XB_TMO], 1u); break; } } } } while (0)

struct XcdBarrier {
    unsigned* bar; unsigned x;
    volatile LAS unsigned* st;
};

__device__ __forceinline__ XcdBarrier xcd_barrier_post(unsigned* bar, volatile LAS unsigned* st) {
    XcdBarrier b; b.bar = bar; b.x = xb_xcc_id(); b.st = st;
    if (threadIdx.x == 0) (void)xb_add(&bar[XB_XCNT(b.x)], 1u);
    return b;
}
__device__ __forceinline__ void xcd_barrier_complete(unsigned* bar, unsigned x, unsigned& nloc, unsigned& nx) {
    const unsigned G = gridDim.x * gridDim.y * gridDim.z;
    unsigned sum, cnt, mine, sp = 0u;
    for (;;) {
        sum = 0u; cnt = 0u; mine = 0u;
#pragma unroll
        for (unsigned j = 0; j < 16; ++j) { const unsigned c = xb_ld(&bar[XB_XCNT(j)]); sum += c; cnt += (c > 0u) ? 1u : 0u; mine = (j == x) ? c : mine; }
        if (sum == G) break;
        __builtin_amdgcn_s_sleep(1);
        if ((++sp & 255u) == 0u) { if (xb_ld(&bar[XB_TMO])) break; if (sp > XB_SPIN_CAP) { atomicAdd(&bar[XB_TMO], 1u); break; } }
    }
    nloc = mine > 0u ? mine : 1u; nx = cnt > 0u ? cnt : 1u;
}

__device__ __forceinline__ void xcd_barrier(const XcdBarrier& b) {
    asm volatile("s_waitcnt vmcnt(0)" ::: "memory");
    __syncthreads();
    if (threadIdx.x == 0) {
        unsigned* bar = b.bar;
        __builtin_amdgcn_s_waitcnt(0);
        unsigned nloc = b.st[0], nx = b.st[1];
        if (nloc == 0u) { xcd_barrier_complete(bar, b.x, nloc, nx); b.st[0] = nloc; b.st[1] = nx; }
        const unsigned old = xb_add(&bar[XB_XSUB(b.x)], 1u);
        const unsigned gen = old / nloc;
        if (old + 1u == (gen + 1u) * nloc) {
            __builtin_amdgcn_fence(__ATOMIC_RELEASE, "agent");
            asm volatile("s_waitcnt vmcnt(0)" ::: "memory");
            const unsigned og = xb_add(&bar[XB_TOP], 1u);
            const unsigned tg = og / nx;
            if (og + 1u == (tg + 1u) * nx) xb_add(&bar[XB_TOPGEN], 1u);
            else XB_SPIN(xb_ld(&bar[XB_TOPGEN]) == tg, bar);
            __builtin_amdgcn_fence(__ATOMIC_ACQUIRE, "agent");
            xb_add(&bar[XB_XGEN(b.x)], 1u);
            asm volatile("s_waitcnt vmcnt(0)" ::: "memory");
        } else {
            XB_SPIN(xb_ld(&bar[XB_XGEN(b.x)]) == gen, bar);
            __builtin_amdgcn_fence(__ATOMIC_ACQUIRE, "agent");
            asm volatile("s_waitcnt vmcnt(0)" ::: "memory");
        }
    }
    __syncthreads();
}

struct Args { const float* in[27]; float* out; unsigned char* ws; int ph_lo, ph_hi; };
struct Frame {
    LAS unsigned char* lds; volatile LAS unsigned* MISC; gu32* ctl;
    int tid, lane, wave, vcu, G;
    const float* const* in; float* out; unsigned char* ws;
};
__device__ __forceinline__ int cond_of_row(int r) { return r < NCTX ? 0 : 1 + ((r - NCTX) >> 10); }
__device__ __forceinline__ const float* xrow_ptr(const float* xp, const float* xs, int r) { return r < NCTX ? xp + (size_t)r * DM : xs + (size_t)(r - NCTX) * DM; }

__device__ __forceinline__ int srcmap_in(int n) {
    if (n < 1024) { const int l = n & 127; return (n & ~127) + 16 * (l >> 5) + (l & 15) + 64 * ((l >> 4) & 1); }
    return (n & ~31) + pg8::perm32(n & 31);
}
template <int WHICH> __device__ __forceinline__ void p0_transpose_item(const float* W, const float* W2, int K, int ld, int N, bf16* WT, LAS float* scr, int item, int lane) {
    const int nblk = N / 32, kb = item / nblk, nb = item % nblk, k0 = 64 * kb, n0 = 32 * nb;
    const int n = n0 + (lane & 31); const float* src; int sc;
    if (WHICH == 0) { src = W; sc = srcmap_in(n); }
    else if (WHICH == 1) { src = W; sc = n; }
    else { const int pn = n >> 8, jj = n & 255, l = jj & 127; src = (jj >> 7) ? W2 : W; sc = 128 * pn + (l & ~31) + pg8::perm32(l & 31); }
#pragma unroll 8
    for (int i = 0; i < 32; ++i) { const int kk = 2 * i + (lane >> 5); scr[kk * 33 + (lane & 31)] = src[(size_t)(k0 + kk) * ld + sc]; }
    LDS_WAIT(); asm volatile("" ::: "memory");
    const int c = lane & 7;
#pragma unroll
    for (int j = 0; j < 4; ++j) { const int nn = (lane >> 3) + 8 * j; const LAS float* s = scr + (8 * c) * 33 + nn;
        v4u o; o.x = pk2(s[0 * 33], s[1 * 33]); o.y = pk2(s[2 * 33], s[3 * 33]); o.z = pk2(s[4 * 33], s[5 * 33]); o.w = pk2(s[6 * 33], s[7 * 33]);
        *(GAS v4u*)(WT + (size_t)(n0 + nn) * K + k0 + 8 * c) = o; }
    LDS_WAIT(); asm volatile("" ::: "memory");
}
__device__ __forceinline__ void p0_prologue(Frame& F) {
    if (F.vcu < 96) {
        LAS float* sl = (LAS float*)(F.lds + RING_OFF);
        LAS float* red = sl + 9 * 1024;
        const float* c_lat = F.in[4]; const float* c_ctx = F.in[5];
        for (int i = F.tid; i < 9 * 1024; i += NWAVES * 64) { const int c = i >> 10, k = i & 1023; const float v = (c == 0) ? c_ctx[k] : c_lat[(size_t)(c - 1) * 1024 + k]; sl[i] = siluf(v); }
        __syncthreads();
        const int n0 = 64 * F.vcu; const float* wa = F.in[25] + n0 + F.lane;
        float acc[9];
#pragma unroll
        for (int c = 0; c < 9; ++c) acc[c] = 0.f;
        const int kbeg = 128 * F.wave;
#pragma unroll 4
        for (int k = kbeg; k < kbeg + 128; ++k) { const float w = wa[(size_t)k * 6144];
#pragma unroll
            for (int c = 0; c < 9; ++c) acc[c] += sl[c * 1024 + k] * w; }
#pragma unroll
        for (int c = 0; c < 9; ++c) red[(F.wave * 9 + c) * 64 + F.lane] = acc[c];
        __syncthreads();
        float* mod = (float*)(F.ws + WS_MOD);
        for (int i = F.tid; i < 9 * 64; i += NWAVES * 64) { const int c = i >> 6, l = i & 63; float s = F.in[26][n0 + l];
#pragma unroll
            for (int w = 0; w < 8; ++w) s += red[(w * 9 + c) * 64 + l];
            mod[(size_t)c * 6144 + n0 + l] = s; }
        __syncthreads();
    }
    if (F.vcu == F.G - 1) { float* rope = (float*)(F.ws + WS_ROPE);
        for (int i = F.tid; i < 64 * 32; i += NWAVES * 64) { const int pos = i >> 5, f = i & 31; const float inv = powf(10000.0f, -(float)f / 32.0f); const float ang = (float)pos * inv;
            rope[2 * i] = (float)cos((double)ang); rope[2 * i + 1] = (float)sin((double)ang); } }
    LAS float* scr = (LAS float*)(F.lds + RING_OFF + F.wave * 16384);
    const int gw = F.vcu * NWAVES + F.wave, NGW = F.G * NWAVES;
    constexpr int I_IN = (DM / 64) * (NPROJ / 32), I_OUT = (DM / 64) * (DM / 32), I_GU = (DM / 64) * (NGU / 32), I_D = (DFF / 64) * (DM / 32);
    constexpr int NITEMS = I_IN + I_OUT + I_GU + I_D;
    for (int it = gw; it < NITEMS; it += NGW) {
        int r = it;
        if (r < I_IN) { p0_transpose_item<0>(F.in[6], nullptr, DM, INCOLS, NPROJ, (bf16*)(F.ws + WS_WIN), scr, r, F.lane); continue; } r -= I_IN;
        if (r < I_OUT) { p0_transpose_item<1>(F.in[17], nullptr, DM, DM, DM, (bf16*)(F.ws + WS_WOUT), scr, r, F.lane); continue; } r -= I_OUT;
        if (r < I_GU) { p0_transpose_item<2>(F.in[20], F.in[21], DM, DFF, NGU, (bf16*)(F.ws + WS_WGU), scr, r, F.lane); continue; } r -= I_GU;
        p0_transpose_item<1>(F.in[22], nullptr, DFF, DM, DM, (bf16*)(F.ws + WS_WD), scr, r, F.lane);
    }
}

__device__ __forceinline__ void p1_hprep(Frame& F) {
    LAS float* wdt = (LAS float*)(F.lds + RING_OFF);
    const float* w_in = F.in[6];
    for (int i = F.tid; i < 8 * 1024; i += NWAVES * 64) { const int k = i >> 3, j = i & 7; wdt[j * 1024 + k] = w_in[(size_t)k * INCOLS + NPROJ + j]; }
    __syncthreads();
    const float* mod = (const float*)(F.ws + WS_MOD); bf16* H1 = (bf16*)(F.ws + WS_H1); float* dtraw = (float*)(F.ws + WS_DTRAW);
    const int gw = F.vcu * NWAVES + F.wave, NGW = F.G * NWAVES;
    for (int r = gw; r < MTOK; r += NGW) {
        const float* xr = xrow_ptr(F.in[0], F.in[1], r); const float* md = mod + (size_t)cond_of_row(r) * 6144;
        float d[8];
#pragma unroll
        for (int j = 0; j < 8; ++j) d[j] = 0.f;
#pragma unroll
        for (int q = 0; q < 4; ++q) { const int col = 4 * F.lane + 256 * q;
            const f32x4 x = *(const f32x4*)(xr + col), sh = *(const f32x4*)(md + col), sc = *(const f32x4*)(md + 1024 + col);
            const f32x4 h = x * (sc + 1.0f) + sh;
            v2u o; o.x = pk2(h[0], h[1]); o.y = pk2(h[2], h[3]); *(v2u*)(H1 + (size_t)r * DM + col) = o;
#pragma unroll
            for (int j = 0; j < 8; ++j) { const f32x4 w = *(const LAS f32x4*)(wdt + j * 1024 + col); d[j] += (h[0] * w[0] + h[1] * w[1]) + (h[2] * w[2] + h[3] * w[3]); } }
#pragma unroll
        for (int j = 0; j < 8; ++j) d[j] = wave_sum(d[j]);
        if (F.lane == 0) {
#pragma unroll
            for (int j = 0; j < 8; ++j) dtraw[(size_t)r * 8 + j] = d[j]; }
    }
}

__device__ __forceinline__ void p3_conv(Frame& F) {
    const bf16* PROJ = (const bf16*)(F.ws + WS_PROJ); bf16* XC = (bf16*)(F.ws + WS_XC);
    const float* cw = F.in[9]; const float* cb = F.in[10];
    const float* dtraw = (const float*)(F.ws + WS_DTRAW); float* dta = (float*)(F.ws + WS_DTA);
    const int gw = F.vcu * NWAVES + F.wave, NGW = F.G * NWAVES;
    for (int r = gw; r < MTOK; r += NGW) {
        int t, L; if (r < NCTX) { t = r & 255; L = 256; } else { t = (r - NCTX) & 1023; L = 1024; }
#pragma unroll
        for (int half = 0; half < 2; ++half) { const int c0 = 8 * F.lane + 512 * half;
            float a[8];
#pragma unroll
            for (int e = 0; e < 8; ++e) a[e] = cb[c0 + e];
#pragma unroll
            for (int w = 0; w < 5; ++w) { const int tt = t + w - 2;
                if (tt >= 0 && tt < L) { const v4u x = *(const v4u*)(PROJ + (size_t)(r + w - 2) * NPROJ + PX + c0); const float* wp = cw + w * 1024 + c0;
                    a[0] += bflo(x.x) * wp[0]; a[1] += bfhi(x.x) * wp[1]; a[2] += bflo(x.y) * wp[2]; a[3] += bfhi(x.y) * wp[3];
                    a[4] += bflo(x.z) * wp[4]; a[5] += bfhi(x.z) * wp[5]; a[6] += bflo(x.w) * wp[6]; a[7] += bfhi(x.w) * wp[7]; } }
            v4u o; o.x = pk2(siluf(a[0]), siluf(a[1])); o.y = pk2(siluf(a[2]), siluf(a[3])); o.z = pk2(siluf(a[4]), siluf(a[5])); o.w = pk2(siluf(a[6]), siluf(a[7]));
            *(v4u*)(XC + (size_t)r * DM + c0) = o; }
        if (F.lane < 8) { const int h = F.lane; const float raw = dtraw[(size_t)r * 8 + h];
            const float dtf = softplusf(raw + F.in[11][h]), dtb = softplusf(raw + F.in[12][h]);
            dta[((size_t)0 * 8 + h) * MTOK + r] = dtf; dta[((size_t)1 * 8 + h) * MTOK + r] = dtb;
            dta[((size_t)2 * 8 + h) * MTOK + r] = -dtf * expf(F.in[13][h]); dta[((size_t)3 * 8 + h) * MTOK + r] = -dtb * expf(F.in[14][h]); }
    }
}

template <int DV> __device__ __forceinline__ void p4_scan_unit(Frame& F, int seq, int h, int dir, bool ssd) {
    constexpr int NDG = 512 / DV, ND = 128 / NDG, TB = 8;
    LAS float* qs = (LAS float*)(F.lds + RING_OFF);
    LAS float* ks = qs + TB * 128;
    LAS float* vs = ks + TB * 128;
    LAS float* as_ = vs + TB * 128;
    LAS float* red = as_ + 64;
    const bf16* PROJ = (const bf16*)(F.ws + WS_PROJ); const bf16* XC = (const bf16*)(F.ws + WS_XC); const float* dta = (const float*)(F.ws + WS_DTA);
    bf16* OF = (bf16*)(F.ws + WS_OF) + (size_t)dir * MTOK * DM;
    const bool lat = seq >= 16; const int L = lat ? 1024 : 256; const int row0 = lat ? NCTX + (seq - 16) * 1024 : seq * 256;
    int e = F.tid % DV, dg = F.tid / DV; asm volatile("" : "+v"(e), "+v"(dg));
    const int d0 = dg * ND;
    float S[ND];
    if (lat) { const int b = seq - 16;
        const float* s0 = ssd ? F.in[3] + (((size_t)b * 2 + dir) * 8 + h) * 8192 : F.in[2] + (((size_t)b * 2 + dir) * 4 + h) * 16384;
#pragma unroll
        for (int i = 0; i < ND; ++i) S[i] = s0[(size_t)(d0 + i) * DV + e];
    } else {
#pragma unroll
        for (int i = 0; i < ND; ++i) S[i] = 0.f; }
    float a_const = 1.f;
    if (!ssd) { const float x = (dir ? F.in[8] : F.in[7])[h]; a_const = expf(-softplusf(-x)); }
    const int ocol = ssd ? 512 + h * 64 + e : h * 128 + e;
    for (int rd = 0; rd < L / TB; ++rd) {
        __syncthreads();
        for (int i = F.tid; i < TB * 128; i += 512) { const int tt = i >> 7, d = i & 127; const int t = dir ? (L - 1 - (rd * TB + tt)) : (rd * TB + tt); const size_t row = row0 + t;
            if (ssd) { const int g = h >> 2; qs[i] = bf2f(XC[row * DM + 768 + g * 128 + d]); ks[i] = bf2f(XC[row * DM + 512 + g * 128 + d]); }
            else { qs[i] = bf2f(PROJ[row * NPROJ + PQ + h * 128 + d]); ks[i] = bf2f(PROJ[row * NPROJ + PK + h * 128 + d]); } }
        for (int i = F.tid; i < TB * DV; i += 512) { const int tt = i / DV, ee = i % DV; const int t = dir ? (L - 1 - (rd * TB + tt)) : (rd * TB + tt); const size_t row = row0 + t;
            if (ssd) vs[tt * 128 + ee] = bf2f(XC[row * DM + h * 64 + ee]) * dta[((size_t)dir * 8 + h) * MTOK + row];
            else vs[tt * 128 + ee] = bf2f(PROJ[row * NPROJ + PV + h * 128 + ee]); }
        if (F.tid < TB) { const int t = dir ? (L - 1 - (rd * TB + F.tid)) : (rd * TB + F.tid); as_[F.tid] = ssd ? expf(dta[((size_t)(2 + dir) * 8 + h) * MTOK + row0 + t]) : a_const; }
        __syncthreads();
        float po[TB];
#pragma unroll
        for (int tt = 0; tt < TB; ++tt) { const float a = as_[tt], v = vs[tt * 128 + e]; float p = 0.f;
#pragma unroll
            for (int i = 0; i < ND; ++i) { const float q = qs[tt * 128 + d0 + i], k = ks[tt * 128 + d0 + i];
                const float sd = a * S[i]; const float sn = sd + k * v; p += q * (dir ? sd : sn); S[i] = sn; }
            po[tt] = p; }
#pragma unroll
        for (int tt = 0; tt < TB; ++tt) red[(dg * TB + tt) * DV + e] = po[tt];
        __syncthreads();
        for (int i = F.tid; i < TB * DV; i += 512) { const int tt = i / DV, ee = i % DV; float s = 0.f;
#pragma unroll
            for (int g = 0; g < NDG; ++g) s += red[(g * TB + tt) * DV + ee];
            const int t = dir ? (L - 1 - (rd * TB + tt)) : (rd * TB + tt);
            OF[(size_t)(row0 + t) * DM + (ssd ? 512 + h * 64 + ee : h * 128 + ee)] = (bf16)f2bf(s); }
    }
    (void)ocol;
    int e2 = e, d2 = d0; asm volatile("" : "+v"(e2), "+v"(d2));
    if (!lat) { float* dst = ssd ? F.out + OUT_SS + (((size_t)seq * 2 + dir) * 8 + h) * 8192 : F.out + OUT_SR + (((size_t)seq * 2 + dir) * 4 + h) * 16384;
#pragma unroll
        for (int i = 0; i < ND; ++i) dst[(size_t)(d2 + i) * DV + e2] = S[i]; }
}
__device__ __forceinline__ void p4_scan_slow(Frame& F) {
    constexpr int NU = 24 * 4 * 2 + 24 * 8 * 2;
    for (int u = F.vcu; u < NU; u += F.G) {
        int seq, h, dir; bool ssd;
        if (u < 64) { ssd = false; seq = 16 + u / 8; h = (u >> 1) & 3; dir = u & 1; }
        else if (u < 192) { const int v = u - 64; ssd = true; seq = 16 + v / 16; h = (v >> 1) & 7; dir = v & 1; }
        else if (u < 320) { const int v = u - 192; ssd = false; seq = v / 8; h = (v >> 1) & 3; dir = v & 1; }
        else { const int v = u - 320; ssd = true; seq = v / 16; h = (v >> 1) & 7; dir = v & 1; }
        if (ssd) p4_scan_unit<64>(F, seq, h, dir, true); else p4_scan_unit<128>(F, seq, h, dir, false);
        __syncthreads();
    }
}

__device__ __forceinline__ void p5_mixprep(Frame& F) {
    const bf16* PROJ = (const bf16*)(F.ws + WS_PROJ); const bf16* XC = (const bf16*)(F.ws + WS_XC);
    const bf16* OF = (const bf16*)(F.ws + WS_OF); const bf16* OB = OF + (size_t)MTOK * DM; bf16* A2 = (bf16*)(F.ws + WS_A2);
    const int gw = F.vcu * NWAVES + F.wave, NGW = F.G * NWAVES;
    for (int r = gw; r < MTOK; r += NGW) {
        {
            const int c0 = 8 * F.lane;
            const v4u f = *(const v4u*)(OF + (size_t)r * DM + c0), b = *(const v4u*)(OB + (size_t)r * DM + c0), g = *(const v4u*)(PROJ + (size_t)r * NPROJ + PG + c0);
            float o[8] = { bflo(f.x) + bflo(b.x), bfhi(f.x) + bfhi(b.x), bflo(f.y) + bflo(b.y), bfhi(f.y) + bfhi(b.y), bflo(f.z) + bflo(b.z), bfhi(f.z) + bfhi(b.z), bflo(f.w) + bflo(b.w), bfhi(f.w) + bfhi(b.w) };
            float ss = 0.f;
#pragma unroll
            for (int e = 0; e < 8; ++e) ss += o[e] * o[e];
#pragma unroll
            for (int m = 1; m < 16; m <<= 1) ss += __shfl_xor(ss, m);
            const float rs = 1.0f / sqrtf(ss * (1.0f / 128.0f) + LN_EPS);
            const float gg[8] = { bflo(g.x), bfhi(g.x), bflo(g.y), bfhi(g.y), bflo(g.z), bfhi(g.z), bflo(g.w), bfhi(g.w) };
            v4u w; w.x = pk2(siluf(gg[0]) * o[0] * rs, siluf(gg[1]) * o[1] * rs); w.y = pk2(siluf(gg[2]) * o[2] * rs, siluf(gg[3]) * o[3] * rs);
            w.z = pk2(siluf(gg[4]) * o[4] * rs, siluf(gg[5]) * o[5] * rs); w.w = pk2(siluf(gg[6]) * o[6] * rs, siluf(gg[7]) * o[7] * rs);
            *(v4u*)(A2 + (size_t)r * DM + c0) = w; }
        {
            const int c0 = 8 * F.lane; const float dsk = F.in[15][F.lane >> 3];
            const v4u f = *(const v4u*)(OF + (size_t)r * DM + 512 + c0), b = *(const v4u*)(OB + (size_t)r * DM + 512 + c0);
            const v4u z = *(const v4u*)(PROJ + (size_t)r * NPROJ + PZ + c0), x = *(const v4u*)(XC + (size_t)r * DM + c0);
            const float zz[8] = { bflo(z.x), bfhi(z.x), bflo(z.y), bfhi(z.y), bflo(z.z), bfhi(z.z), bflo(z.w), bfhi(z.w) };
            const float xx[8] = { bflo(x.x), bfhi(x.x), bflo(x.y), bfhi(x.y), bflo(x.z), bfhi(x.z), bflo(x.w), bfhi(x.w) };
            float y[8] = { bflo(f.x) + bflo(b.x), bfhi(f.x) + bfhi(b.x), bflo(f.y) + bflo(b.y), bfhi(f.y) + bfhi(b.y), bflo(f.z) + bflo(b.z), bfhi(f.z) + bfhi(b.z), bflo(f.w) + bflo(b.w), bfhi(f.w) + bfhi(b.w) };
            float ss = 0.f;
#pragma unroll
            for (int e = 0; e < 8; ++e) { y[e] = (y[e] + dsk * xx[e]) * siluf(zz[e]); ss += y[e] * y[e]; }
            ss = wave_sum(ss);
            const float rs = 1.0f / sqrtf(ss * (1.0f / 512.0f) + LN_EPS); const float* nw = F.in[16] + c0;
            v4u w; w.x = pk2(y[0] * rs * nw[0], y[1] * rs * nw[1]); w.y = pk2(y[2] * rs * nw[2], y[3] * rs * nw[3]); w.z = pk2(y[4] * rs * nw[4], y[5] * rs * nw[5]); w.w = pk2(y[6] * rs * nw[6], y[7] * rs * nw[7]);
            *(v4u*)(A2 + (size_t)r * DM + 512 + c0) = w; }
    }
}

template <bool MAKE_H> __device__ __forceinline__ void ln_rows(Frame& F, const float* T, const float* g, const float* b, float* Y, bf16* H, int sh_off) {
    const float* mod = (const float*)(F.ws + WS_MOD);
    const int gw = F.vcu * NWAVES + F.wave, NGW = F.G * NWAVES;
    for (int r = gw; r < MTOK; r += NGW) {
        const float* tr = T + (size_t)r * DM; f32x4 v[4]; float s = 0.f;
#pragma unroll
        for (int q = 0; q < 4; ++q) { v[q] = *(const f32x4*)(tr + 4 * F.lane + 256 * q); s += (v[q][0] + v[q][1]) + (v[q][2] + v[q][3]); }
        const float mean = wave_sum(s) * (1.f / DM); float s2 = 0.f;
#pragma unroll
        for (int q = 0; q < 4; ++q) { v[q] = v[q] - mean; s2 += (v[q][0] * v[q][0] + v[q][1] * v[q][1]) + (v[q][2] * v[q][2] + v[q][3] * v[q][3]); }
        const float rstd = 1.f / sqrtf(wave_sum(s2) * (1.f / DM) + LN_EPS);
        const float* md = mod + (size_t)cond_of_row(r) * 6144;
#pragma unroll
        for (int q = 0; q < 4; ++q) { const int col = 4 * F.lane + 256 * q;
            const f32x4 y = v[q] * rstd * *(const f32x4*)(g + col) + *(const f32x4*)(b + col);
            *(f32x4*)(Y + (size_t)r * DM + col) = y;
            if (MAKE_H) { const f32x4 h = y * (*(const f32x4*)(md + sh_off + 1024 + col) + 1.0f) + *(const f32x4*)(md + sh_off + col);
                v2u o; o.x = pk2(h[0], h[1]); o.y = pk2(h[2], h[3]); *(v2u*)(H + (size_t)r * DM + col) = o; } }
    }
}


constexpr int SC_Q = 0, SC_K = 16384, SC_V = 32768, SC_VW = 49152, SC_P = 65536, SC_S = 81920, SC_ARR = SC_S + 64 * 68 * 4;
static_assert(SC_ARR + 2 * 2 * 5 * 64 * 4 <= RING_BYTES, "scan LDS map");
typedef short sbf16x8 __attribute__((ext_vector_type(8)));
typedef short s16x4_t __attribute__((ext_vector_type(4)));
__device__ __forceinline__ unsigned offb(unsigned row, unsigned ch) { return 256u * row + 16u * (ch ^ (((row & 3u) << 2) | ((row >> 2) & 3u))); }
__device__ __forceinline__ s16x4_t ds_tr(LAS unsigned char* p) { return __builtin_amdgcn_ds_read_tr16_b64_v4i16((LAS s16x4_t*)p); }
__device__ __forceinline__ sbf16x8 tr_frag(LAS unsigned char* img, unsigned lane, unsigned c, unsigned ks) {
    const unsigned g = lane >> 4, q = (lane & 15) >> 2, p = lane & 3;
    const s16x4_t lo = ds_tr(img + offb(32 * ks + 8 * g + q, 2 * c + (p >> 1)) + 8 * (p & 1));
    const s16x4_t hi = ds_tr(img + offb(32 * ks + 8 * g + 4 + q, 2 * c + (p >> 1)) + 8 * (p & 1));
    return __builtin_shufflevector(lo, hi, 0, 1, 2, 3, 4, 5, 6, 7);
}
__device__ __forceinline__ unsigned cvtpk(float lo, float hi) { unsigned r; asm volatile("v_cvt_pk_bf16_f32 %0, %1, %2" : "=v"(r) : "v"(lo), "v"(hi)); return r; }
__device__ __forceinline__ void scan_unit_fast(Frame& F, int seq, int kh, int dir) {
    LAS unsigned char* L = F.lds + RING_OFF;
    const bool ssd = kh >= 4; const int hq = kh & 3;
    const bool lat = seq >= 16; const int NCH = lat ? 16 : 4; const int row0 = lat ? NCTX + (seq - 16) * 1024 : seq * 256;
    int lane = F.lane, wv = F.wave; asm volatile("" : "+v"(lane));
    const int hh = wv >> 2, te = wv & 3, g = lane >> 4, l15 = lane & 15, tid = wv * 64 + lane;
    const bf16* PROJ = (const bf16*)(F.ws + WS_PROJ); const bf16* XC = (const bf16*)(F.ws + WS_XC); const float* dta = (const float*)(F.ws + WS_DTA);
    const bf16 *qsrc, *ksrc, *vsrc; int sstr;
    if (ssd) { const int gq = hq >> 1; qsrc = XC + 768 + gq * 128; ksrc = XC + 512 + gq * 128; vsrc = XC + hq * 128; sstr = DM; }
    else { qsrc = PROJ + PQ + hq * 128; ksrc = PROJ + PK + hq * 128; vsrc = PROJ + PV + hq * 128; sstr = NPROJ; }
    bf16* OF = (bf16*)(F.ws + WS_OF) + (size_t)dir * MTOK * DM + (ssd ? 512 + hq * 128 : hq * 128) + 64 * hh + 16 * te + l15;
    const int head = ssd ? 2 * hq + hh : hq;
    float lg = 0.f; if (!ssd) { const float x = (dir ? F.in[8] : F.in[7])[hq]; lg = -softplusf(-x); }
    const float* la_src = dta + ((size_t)(2 + dir) * 8 + head) * MTOK + row0; const float* dt_src = dta + ((size_t)dir * 8 + head) * MTOK + row0;
    const int ldS = ssd ? 64 : 128, scol = (ssd ? 0 : 64 * hh) + 16 * te + l15;
    f32x4 st[8];
    if (lat) { const int b = seq - 16; const float* s0 = ssd ? F.in[3] + (((size_t)b * 2 + dir) * 8 + head) * 8192 : F.in[2] + (((size_t)b * 2 + dir) * 4 + head) * 16384;
#pragma unroll
        for (int td = 0; td < 8; ++td)
#pragma unroll
            for (int r = 0; r < 4; ++r) st[td][r] = s0[(size_t)(16 * td + 4 * g + r) * ldS + scol];
    } else {
#pragma unroll
        for (int td = 0; td < 8; ++td) st[td] = (f32x4){0.f, 0.f, 0.f, 0.f}; }
    sbf16x8 stf[4];
#define SC_PACK_STATE() do { _Pragma("unroll") for (int kd = 0; kd < 4; ++kd) { v4u w_; w_.x = cvtpk(st[2 * kd][0], st[2 * kd][1]); w_.y = cvtpk(st[2 * kd][2], st[2 * kd][3]); \
        w_.z = cvtpk(st[2 * kd + 1][0], st[2 * kd + 1][1]); w_.w = cvtpk(st[2 * kd + 1][2], st[2 * kd + 1][3]); stf[kd] = __builtin_bit_cast(sbf16x8, w_); } } while (0)
    SC_PACK_STATE();
#define SC_ARRAYS(bufi, laj, wj) do { float c_ = (laj); \
        if (!dir) { _Pragma("unroll") for (int o_ = 1; o_ < 64; o_ <<= 1) { const float t_ = __shfl_up(c_, o_); if (lane >= o_) c_ += t_; } } \
        else { _Pragma("unroll") for (int o_ = 1; o_ < 64; o_ <<= 1) { const float t_ = __shfl_down(c_, o_); if (lane + o_ < 64) c_ += t_; } } \
        const float cend_ = __shfl(c_, dir ? 0 : 63); LAS float* a_ = (LAS float*)(L + SC_ARR) + ((bufi) * 2 + hh) * 320; \
        a_[lane] = c_; a_[64 + lane] = (wj); a_[128 + lane] = __expf(cend_ - c_) * (wj); a_[192 + lane] = __expf(c_); if (lane == 0) a_[256] = __expf(cend_); } while (0)
    v4u rq[2], rk[2], rv[2]; float r_la = 0.f, r_dt = 1.f;
#define SC_LOAD(n) do { const size_t rb_ = (size_t)row0 + 64 * (n); _Pragma("unroll") for (int i_ = 0; i_ < 2; ++i_) { const int id_ = tid + 512 * i_; const size_t o_ = (rb_ + (id_ >> 4)) * sstr + (id_ & 15) * 8; \
        rq[i_] = *(const v4u*)(qsrc + o_); rk[i_] = *(const v4u*)(ksrc + o_); rv[i_] = *(const v4u*)(vsrc + o_); } \
        if (te == 0) { if (ssd) { r_la = la_src[64 * (n) + lane]; r_dt = dt_src[64 * (n) + lane]; } else { r_la = lg; r_dt = 1.f; } } } while (0)
    __syncthreads();
    { const int n0 = dir ? NCH - 1 : 0; SC_LOAD(n0); if (te == 0) SC_ARRAYS(0, r_la, r_dt); }
    __syncthreads();
    for (int s = 0; s < NCH; ++s) {
        const int n = dir ? NCH - 1 - s : s, buf = s & 1;
        const LAS float* arr = (const LAS float*)(L + SC_ARR) + (buf * 2) * 320;
#pragma unroll
        for (int i = 0; i < 2; ++i) { const int id = tid + 512 * i; const unsigned row = id >> 4, ch = id & 15, ob = offb(row, ch);
            *(LAS v4u*)(L + SC_Q + ob) = rq[i]; *(LAS v4u*)(L + SC_K + ob) = rk[i]; *(LAS v4u*)(L + SC_V + ob) = rv[i];
            const float wt = arr[(ch >> 3) * 320 + 128 + row]; v4u w;
            w.x = cvtpk(bflo(rv[i].x) * wt, bfhi(rv[i].x) * wt); w.y = cvtpk(bflo(rv[i].y) * wt, bfhi(rv[i].y) * wt); w.z = cvtpk(bflo(rv[i].z) * wt, bfhi(rv[i].z) * wt); w.w = cvtpk(bflo(rv[i].w) * wt, bfhi(rv[i].w) * wt);
            *(LAS v4u*)(L + SC_VW + ob) = w; }
        __syncthreads();
        if (s + 1 < NCH) { const int nn = dir ? n - 1 : n + 1; SC_LOAD(nn); }
        { const int ti = wv >> 1, tj0 = 2 * (wv & 1); f32x4 sa[2] = {(f32x4){0.f, 0.f, 0.f, 0.f}, (f32x4){0.f, 0.f, 0.f, 0.f}};
#pragma unroll
            for (int ks = 0; ks < 4; ++ks) { const sbf16x8 bq = *(const LAS sbf16x8*)(L + SC_Q + offb(16 * ti + l15, 4 * ks + g));
#pragma unroll
                for (int t = 0; t < 2; ++t) { const sbf16x8 ak = *(const LAS sbf16x8*)(L + SC_K + offb(16 * (tj0 + t) + l15, 4 * ks + g)); sa[t] = __builtin_amdgcn_mfma_f32_16x16x32_bf16(ak, bq, sa[t], 0, 0, 0); } }
#pragma unroll
            for (int t = 0; t < 2; ++t) *(LAS f32x4*)(L + SC_S + ((16 * ti + l15) * 68 + 16 * (tj0 + t) + 4 * g) * 4) = sa[t]; }
        __syncthreads();
        { const int t256 = tid & 255, i = t256 >> 2, q4 = t256 & 3; const LAS float* ah = arr + hh * 320; const float ci = ah[i]; unsigned pw[8];
#pragma unroll
            for (int m = 0; m < 4; ++m) { const f32x4 s4 = *(const LAS f32x4*)(L + SC_S + (i * 68 + 16 * q4 + 4 * m) * 4), c4 = *(const LAS f32x4*)(ah + 16 * q4 + 4 * m), w4 = *(const LAS f32x4*)(ah + 64 + 16 * q4 + 4 * m);
                float p[4];
#pragma unroll
                for (int e = 0; e < 4; ++e) { const int j = 16 * q4 + 4 * m + e; const bool valid = dir ? (j > i) : (j <= i); p[e] = valid ? s4[e] * __expf(ci - c4[e]) * w4[e] : 0.f; }
                pw[2 * m] = cvtpk(p[0], p[1]); pw[2 * m + 1] = cvtpk(p[2], p[3]); }
            *(LAS v4u*)(L + SC_P + offb(i, hh * 8 + 2 * q4)) = (v4u){pw[0], pw[1], pw[2], pw[3]}; *(LAS v4u*)(L + SC_P + offb(i, hh * 8 + 2 * q4 + 1)) = (v4u){pw[4], pw[5], pw[6], pw[7]}; }
        if (te == 0 && s + 1 < NCH) SC_ARRAYS(buf ^ 1, r_la, r_dt);
        __syncthreads();
        { const int eb = hh * 4 + te; const LAS float* ah = arr + hh * 320;
            f32x4 ao[4], ac[4];
#pragma unroll
            for (int ti = 0; ti < 4; ++ti) { ao[ti] = (f32x4){0.f, 0.f, 0.f, 0.f}; ac[ti] = (f32x4){0.f, 0.f, 0.f, 0.f}; }
            sbf16x8 vfr[2]; vfr[0] = tr_frag(L + SC_V, lane, eb, 0); vfr[1] = tr_frag(L + SC_V, lane, eb, 1);
#pragma unroll
            for (int ti = 0; ti < 4; ++ti) {
#pragma unroll
                for (int ks = 0; ks < 2; ++ks) { const sbf16x8 pa = *(const LAS sbf16x8*)(L + SC_P + offb(16 * ti + l15, hh * 8 + 4 * ks + g)); ao[ti] = __builtin_amdgcn_mfma_f32_16x16x32_bf16(pa, vfr[ks], ao[ti], 0, 0, 0); }
#pragma unroll
                for (int kd = 0; kd < 4; ++kd) { const v2u lo = *(const LAS v2u*)(L + SC_Q + offb(16 * ti + l15, 4 * kd + (g >> 1)) + 8 * (g & 1)), hi = *(const LAS v2u*)(L + SC_Q + offb(16 * ti + l15, 4 * kd + 2 + (g >> 1)) + 8 * (g & 1));
                    const sbf16x8 qa = __builtin_bit_cast(sbf16x8, (v4u){lo.x, lo.y, hi.x, hi.y}); ac[ti] = __builtin_amdgcn_mfma_f32_16x16x32_bf16(qa, stf[kd], ac[ti], 0, 0, 0); } }
            bf16* orow = OF + ((size_t)row0 + 64 * n + 4 * g) * DM;
#pragma unroll
            for (int ti = 0; ti < 4; ++ti) { const f32x4 ec4 = *(const LAS f32x4*)(ah + 192 + 16 * ti + 4 * g);
#pragma unroll
                for (int r = 0; r < 4; ++r) orow[(size_t)(16 * ti + r) * DM] = (bf16)f2bf(ao[ti][r] + ec4[r] * ac[ti][r]); }
            const float ce = ah[256];
#pragma unroll
            for (int td = 0; td < 8; ++td) st[td] = st[td] * ce;
            sbf16x8 wfr[2]; wfr[0] = tr_frag(L + SC_VW, lane, eb, 0); wfr[1] = tr_frag(L + SC_VW, lane, eb, 1);
#pragma unroll
            for (int td = 0; td < 8; ++td)
#pragma unroll
                for (int ks = 0; ks < 2; ++ks) { const sbf16x8 ka = tr_frag(L + SC_K, lane, td, ks); st[td] = __builtin_amdgcn_mfma_f32_16x16x32_bf16(ka, wfr[ks], st[td], 0, 0, 0); }
            SC_PACK_STATE(); }
        __syncthreads();
    }
    if (!lat) { float* dst = ssd ? F.out + OUT_SS + (((size_t)seq * 2 + dir) * 8 + head) * 8192 : F.out + OUT_SR + (((size_t)seq * 2 + dir) * 4 + head) * 16384;
#pragma unroll
        for (int td = 0; td < 8; ++td)
#pragma unroll
            for (int r = 0; r < 4; ++r) dst[(size_t)(16 * td + 4 * g + r) * ldS + scol] = st[td][r]; }
#undef SC_PACK_STATE
#undef SC_ARRAYS
#undef SC_LOAD
}
__device__ __forceinline__ void p4_scan_fast(Frame& F) {
    for (int it = 0; ; ++it) {
        int u;
        if (F.G == 256) { if (F.vcu < 128) { if (it > 0) break; u = F.vcu; } else { if (it > 1) break; u = 128 + 2 * (F.vcu - 128) + it; } }
        else { u = F.vcu + it * F.G; if (u >= 384) break; }
        int seq, kh, dir;
        if (u < 128) { seq = 16 + (u >> 4); kh = (u >> 1) & 7; dir = u & 1; } else { const int v = u - 128; seq = v >> 4; kh = (v >> 1) & 7; dir = v & 1; }
        scan_unit_fast(F, seq, kh, dir);
    }
}
__global__ void __launch_bounds__(NWAVES * 64, 2) mk_fwd(Args args) {
    extern __shared__ __attribute__((aligned(16))) unsigned char lds[];
    Frame F;
    F.lds = (LAS unsigned char*)lds; F.MISC = (volatile LAS unsigned*)(F.lds + MISC_OFF);
    F.wave = __builtin_amdgcn_readfirstlane(threadIdx.x >> 6); F.lane = (int)__builtin_amdgcn_mbcnt_hi(~0u, __builtin_amdgcn_mbcnt_lo(~0u, 0u)); F.tid = F.wave * 64 + F.lane;
    F.G = gridDim.x; { const int bx = blockIdx.x; F.vcu = (F.G % 8 == 0) ? (bx % 8) * (F.G / 8) + bx / 8 : bx; }
    F.in = args.in; F.out = args.out; F.ws = args.ws; F.ctl = (gu32*)(args.ws + WS_CTL);
    for (int u = F.tid; u < (LDS_BYTES - LDSCTL_OFF) / 4; u += NWAVES * 64) ((LAS unsigned*)(F.lds + LDSCTL_OFF))[u] = 0u;
    __syncthreads();
    XcdBarrier bar; bar.bar = (unsigned*)(F.ctl + CW_BAR); bar.x = 0; bar.st = nullptr;
    if (!MK_PER_PHASE) bar = xcd_barrier_post((unsigned*)(F.ctl + CW_BAR), F.MISC + 8);
    const int lo = args.ph_lo, hi = args.ph_hi;
#define IN(k) (lo <= (k) && (k) < hi)
#define SEAM(k) do { if (IN(k) && IN((k) + 1)) xcd_barrier(bar); } while (0)
    unsigned char* ws = args.ws;
    if (IN(0)) { p0_prologue(F); SEAM(0); }
    if (IN(1)) { p1_hprep(F); SEAM(1); }
    if (IN(2)) {
        pg8::Gemm g{(const pg8::bf16_t*)(ws + WS_H1), (const pg8::bf16_t*)(ws + WS_WIN), MTOK, NPROJ, DM}; pg8::StaticOrder S; S.init(MTOK, NPROJ, F.G, (int)blockIdx.x);
        pg8::EpiIn E{(pg8::bf16_t*)(ws + WS_PROJ), (const float*)(ws + WS_ROPE)};
        pg8::gemm_phase<pg8::EpiIn, pg8::StaticOrder, true, true>(F.lds + RING_OFF, g, S, E);
        SEAM(2);
    }
    if (IN(3)) { p3_conv(F); SEAM(3); }
    if (IN(4)) { p4_scan_fast(F); SEAM(4); }
    if (IN(5)) { p5_mixprep(F); SEAM(5); }
    if (IN(6)) {
        pg8::Gemm g{(const pg8::bf16_t*)(ws + WS_A2), (const pg8::bf16_t*)(ws + WS_WOUT), MTOK, DM, DM}; pg8::StaticOrder S; S.init(MTOK, DM, F.G, (int)blockIdx.x);
        pg8::EpiRes E{(float*)(ws + WS_T1), F.in[0], F.in[1], (const float*)(ws + WS_MOD) + 2048, ALPHA};
        pg8::gemm_phase<pg8::EpiRes, pg8::StaticOrder, true, true>(F.lds + RING_OFF, g, S, E);
        SEAM(6);
    }
    if (IN(7)) { ln_rows<true>(F, (const float*)(ws + WS_T1), F.in[18], F.in[19], F.out, (bf16*)(ws + WS_H2), 3072); SEAM(7); }
    if (IN(8)) {
        pg8::Gemm g{(const pg8::bf16_t*)(ws + WS_H2), (const pg8::bf16_t*)(ws + WS_WGU), MTOK, NGU, DM}; pg8::StaticOrder S; S.init(MTOK, NGU, F.G, (int)blockIdx.x);
        pg8::EpiGU E{(pg8::bf16_t*)(ws + WS_ACT)};
        pg8::gemm_phase<pg8::EpiGU, pg8::StaticOrder, true, true>(F.lds + RING_OFF, g, S, E);
        SEAM(8);
    }
    if (IN(9)) {
        pg8::Gemm g{(const pg8::bf16_t*)(ws + WS_ACT), (const pg8::bf16_t*)(ws + WS_WD), MTOK, DM, DFF}; pg8::StaticOrder S; S.init(MTOK, DM, F.G, (int)blockIdx.x);
        pg8::EpiRes E{(float*)(ws + WS_T2), F.out, F.out + (size_t)NCTX * DM, (const float*)(ws + WS_MOD) + 5120, ALPHA};
        pg8::gemm_phase<pg8::EpiRes, pg8::StaticOrder, true, true>(F.lds + RING_OFF, g, S, E);
        SEAM(9);
    }
    if (IN(10)) { ln_rows<false>(F, (const float*)(ws + WS_T2), F.in[23], F.in[24], F.out, nullptr, 0); }
#undef IN
#undef SEAM
}

extern "C" void kernel_launch(void* const* d_in, const int* in_sizes, int n_in, void* d_out, int out_size, void* d_ws, size_t ws_size, hipStream_t stream) {
    static int grid = 0;
    if (grid == 0) {
        if (n_in != 27 || out_size != 16777216 || ws_size < WS_END) { fprintf(stderr, "kernel_launch: unexpected shapes (n_in %d, out %d, ws %zu); nothing launched\n", n_in, out_size, ws_size); grid = -1; return; }
        int dev = 0, cus = 0, per_cu = 0;
        if (hipGetDevice(&dev) != hipSuccess || hipDeviceGetAttribute(&cus, hipDeviceAttributeMultiprocessorCount, dev) != hipSuccess) { grid = -1; return; }
        if (hipFuncSetAttribute((const void*)mk_fwd, hipFuncAttributeMaxDynamicSharedMemorySize, LDS_BYTES) != hipSuccess) { fprintf(stderr, "kernel_launch: hipFuncSetAttribute failed\n"); grid = -1; return; }
        if (hipOccupancyMaxActiveBlocksPerMultiprocessor(&per_cu, (const void*)mk_fwd, NWAVES * 64, LDS_BYTES) != hipSuccess || per_cu < 1) fprintf(stderr, "kernel_launch: note: occupancy query reports %d\n", per_cu);
        (void)hipGetLastError();
        grid = cus;
    }
    if (grid < 0) return;
    if (hipMemsetAsync((char*)d_ws + WS_CTL, 0, CTL_ZERO_BYTES, stream) != hipSuccess) return;
    Args a{};
    for (int i = 0; i < 27; ++i) a.in[i] = (const float*)d_in[i];
    a.out = (float*)d_out; a.ws = (unsigned char*)d_ws;
#if MK_PER_PHASE
    for (int p = 0; p < N_PHASES; ++p) { a.ph_lo = p; a.ph_hi = p + 1; hipLaunchKernelGGL(mk_fwd, dim3(grid), dim3(NWAVES * 64), LDS_BYTES, stream, a); }
#else
    a.ph_lo = 0; a.ph_hi = N_PHASES; hipLaunchKernelGGL(mk_fwd, dim3(grid), dim3(NWAVES * 64), LDS_BYTES, stream, a);
#endif
}
```
